# Optimizing an MI355X kernel written in HIP

```python
import math
import jax
import jax.numpy as jnp
from jax import lax
import numpy as np

D_MODEL = 2048
BATCH = 1
SEQ = 8192
DEPTH = 4

GRID_W = 64
CTX_LEN = 256
EPS = 1e-6
POS_BASE = 10000.0

D_S5 = D_MODEL // 4
S5_GROUP = 16
S5_GROUPS = D_S5 // S5_GROUP
S5_STATE = 64
S5_DT_MIN = 1e-3
S5_DT_MAX = 1e-1

GLA_HEADS = 4
D_GLA_K = D_MODEL // 4
D_GLA_V = D_MODEL // 2
GLA_DK = D_GLA_K // GLA_HEADS
GLA_DV = D_GLA_V // GLA_HEADS
GLA_RANK = 16
GLA_TAU = 16.0
GLA_CHUNK = 64

D_HY = D_MODEL // 4
HY_SHORT = 3
HY_BANDS = 16
HY_FEAT = 1 + 2 * HY_BANDS
HY_HIDDEN = 64
HY_TARGET = 1e-2
HY_MIN_DECAY = -math.log(HY_TARGET) / 1.5
HY_MAX_DECAY = -math.log(HY_TARGET) / 0.3
HY_FILTER_SCALE = 0.05

D_MIX = D_S5 + D_GLA_V + D_HY
IN_NAMES = ('s5', 'q', 'k', 'v', 'gate', 'alpha', 'hy')
IN_WIDTHS = (D_S5, D_GLA_K, D_GLA_K, D_GLA_V, D_GLA_V, 2 * GLA_RANK, 3 * D_HY)
IN_WIDTH = sum(IN_WIDTHS)

PEER_HEADS = 8
PEER_KEYS = 128
PEER_EXPERTS = PEER_KEYS * PEER_KEYS
PEER_DQ = 256
PEER_TOPK = 16
PEER_BLOCK = 128

F32 = jnp.float32

kernel_name = 'hybrid_s5_gla_hyena_peer_dit'


def rmsnorm(x, g):
    xf = x.astype(F32)
    y = xf * lax.rsqrt(jnp.mean(jnp.square(xf), axis=-1, keepdims=True) + EPS)
    return (y * g.astype(F32)).astype(x.dtype)


def modulate(x, g, shift, scale):
    return rmsnorm(x, g) * (1.0 + scale) + shift


def grid_sincos(n_tokens, dim, dtype):
    rows = n_tokens // GRID_W
    row = jnp.repeat(jnp.arange(rows), GRID_W).astype(F32)
    col = jnp.tile(jnp.arange(GRID_W), rows).astype(F32)
    n_freq = dim // 4
    omega = 1.0 / (POS_BASE ** (jnp.arange(n_freq, dtype=F32) / n_freq))
    def enc(p):
        a = p[:, None] * omega[None, :]
        return jnp.concatenate([jnp.sin(a), jnp.cos(a)], axis=-1)
    return jnp.concatenate([enc(row), enc(col)], axis=-1).astype(dtype)


def split_in(p):
    cuts = np.cumsum(IN_WIDTHS)[:-1].tolist()
    return dict(zip(IN_NAMES, jnp.split(p, cuts, axis=-1)))


def _rev(t, axis, rev):
    return jnp.flip(t, axis) if rev else t


def _lin_combine(e1, e2):
    a1, b1 = e1
    a2, b2 = e2
    return a2 * a1, a2 * b1 + b2


def s5_discretise(a_re, a_im, log_step, b_re, b_im):
    lam = lax.complex(a_re.astype(F32), a_im.astype(F32))
    lam_bar = jnp.exp(lam * jnp.exp(log_step.astype(F32))[:, None])
    b = lax.complex(b_re.astype(F32), b_im.astype(F32))
    b_bar = ((lam_bar - 1.0) / lam)[..., None] * b
    return lam_bar, b_bar


def s5_scan(u, lam_bar, b_bar, h0=None):
    bu = lax.complex(jnp.einsum('blgc,gpc->blgp', u, b_bar.real),
                     jnp.einsum('blgc,gpc->blgp', u, b_bar.imag))
    if h0 is not None:
        bu = bu.at[:, 0].add(lam_bar * h0)
    a = jnp.broadcast_to(lam_bar, bu.shape)
    _, h = lax.associative_scan(_lin_combine, (a, bu), axis=1)
    return h


def s5_readout(h, c_re, c_im):
    return (jnp.einsum('blgp,gcp->blgc', h.real, c_re)
            - jnp.einsum('blgp,gcp->blgc', h.imag, c_im))


def s5_mixer(u_c, u_l, a_re, a_im, log_step, b_re, b_im, c_re, c_im, d, w_glu, b_glu, ctx_out):
    dtype = u_l.dtype
    grp = lambda t: t.astype(F32).reshape(t.shape[0], t.shape[1], S5_GROUPS, S5_GROUP)
    uc, ul = grp(u_c), grp(u_l)
    y_c, y_l = 0.0, 0.0
    for dr in range(2):
        rev = dr == 1
        lam_bar, b_bar = s5_discretise(a_re[dr], a_im[dr], log_step[dr], b_re[dr], b_im[dr])
        cr, ci = c_re[dr].astype(F32), c_im[dr].astype(F32)
        h_c = s5_scan(_rev(uc, 1, rev), lam_bar, b_bar)
        h_l = s5_scan(_rev(ul, 1, rev), lam_bar, b_bar, h_c[:, -1])
        y_l = y_l + _rev(s5_readout(h_l, cr, ci), 1, rev)
        if ctx_out:
            y_c = y_c + _rev(s5_readout(h_c, cr, ci), 1, rev)
    def finish(y, u):
        y = y.reshape(u.shape) + d.astype(F32) * u.astype(F32)
        z = jax.nn.gelu(y)
        return (z * jax.nn.sigmoid(z @ w_glu.astype(F32) + b_glu.astype(F32))).astype(dtype)
    return (finish(y_c, u_c) if ctx_out else None), finish(y_l, u_l)


def _heads(t, dh):
    B, n, _ = t.shape
    return t.astype(F32).reshape(B, n, GLA_HEADS, dh).transpose(0, 2, 1, 3)


def _gla_prep(p, w_alpha, b_alpha):
    B, n, _ = p['q'].shape
    q = _heads(p['q'], GLA_DK) * GLA_DK ** -0.5
    k = _heads(p['k'], GLA_DK)
    v = _heads(p['v'], GLA_DV)
    lr = p['alpha'].astype(F32).reshape(B, n, 2, GLA_RANK)
    logs = [_heads(jax.nn.log_sigmoid(lr[:, :, dr] @ w_alpha[dr].astype(F32)
                                      + b_alpha[dr].astype(F32)) / GLA_TAU, GLA_DK)
            for dr in range(2)]
    return q, k, v, logs


def gla_chunked(q, k, v, g, s0):
    B, H, n, dk = q.shape
    nc = n // GLA_CHUNK
    rs = lambda t: t.reshape(B, H, nc, GLA_CHUNK, t.shape[-1])
    q, k, v, g = rs(q), rs(k), rs(v), rs(g)
    b = jnp.cumsum(g, axis=3)
    b_last = b[:, :, :, -1:]
    q_d = q * jnp.exp(b)
    att = jnp.einsum('bhnik,bhnjk->bhnij', q_d, k * jnp.exp(-b))
    mask = jnp.tril(jnp.ones((GLA_CHUNK, GLA_CHUNK), dtype=bool))
    o_intra = jnp.einsum('bhnij,bhnjv->bhniv', jnp.where(mask, att, 0.0), v)
    d_state = jnp.einsum('bhnck,bhncv->nbhkv', k * jnp.exp(b_last - b), v)
    decay = jnp.moveaxis(jnp.exp(b_last[:, :, :, 0]), 2, 0)
    def step(s, inp):
        dec, ds = inp
        return dec[..., None] * s + ds, s
    s_fin, s_prev = lax.scan(step, s0, (decay, d_state))
    o_inter = jnp.einsum('bhnck,nbhkv->bhncv', q_d, s_prev)
    return (o_intra + o_inter).reshape(B, H, n, v.shape[-1]), s_fin


def gla_final_state(k, v, g):
    cum = jnp.cumsum(g, axis=2)
    return jnp.einsum('bhlk,bhlv->bhkv', k * jnp.exp(cum[:, :, -1:] - cum), v)


def gla_mixer(p_c, p_l, w_alpha, b_alpha, g_norm, ctx_out):
    dtype = p_l['v'].dtype
    qc, kc, vc, gc = _gla_prep(p_c, w_alpha, b_alpha)
    ql, kl, vl, gl = _gla_prep(p_l, w_alpha, b_alpha)
    o_c, o_l = 0.0, 0.0
    for dr in range(2):
        rev = dr == 1
        f = lambda t, rev=rev: _rev(t, 2, rev)
        if ctx_out:
            s0 = jnp.zeros(kc.shape[:2] + (GLA_DK, GLA_DV), F32)
            oc, s_ctx = gla_chunked(f(qc), f(kc), f(vc), f(gc[dr]), s0)
            o_c = o_c + f(oc)
        else:
            s_ctx = gla_final_state(f(kc), f(vc), f(gc[dr]))
        ol, _ = gla_chunked(f(ql), f(kl), f(vl), f(gl[dr]), s_ctx)
        o_l = o_l + f(ol)
    def finish(o, gate):
        B, H, n, _ = o.shape
        o = rmsnorm(o, g_norm).transpose(0, 2, 1, 3).reshape(B, n, D_GLA_V)
        return (o * jax.nn.silu(gate.astype(F32))).astype(dtype)
    return (finish(o_c, p_c['gate']) if ctx_out else None), finish(o_l, p_l['gate'])


def short_conv(x, w, b):
    C = x.shape[-1]
    y = lax.conv_general_dilated(x, w.astype(F32)[:, None, :], window_strides=(1,),
                                 padding=[(HY_SHORT // 2, HY_SHORT // 2)],
                                 dimension_numbers=('NWC', 'WIO', 'NWC'),
                                 feature_group_count=C)
    return y + b.astype(F32)


def hyena_filter(n, w1, b1, w2, b2, w3, freq, decay):
    t = jnp.linspace(0.0, 1.0, n, dtype=F32)[:, None]
    w = 2.0 * math.pi * jnp.arange(n, dtype=F32)[:, None] / n
    bands = jnp.linspace(1e-4, HY_BANDS - 1, HY_BANDS, dtype=F32)[None, :]
    z = jnp.concatenate([t, jnp.cos(bands * w), -jnp.sin(bands * w)], axis=-1)
    freq = freq.astype(F32)
    h = jnp.sin(freq[0] * (z @ w1.astype(F32) + b1.astype(F32)))
    h = jnp.sin(freq[1] * (h @ w2.astype(F32) + b2.astype(F32)))
    h = (h @ w3.astype(F32)).reshape(n, 2, D_HY)
    return h * jnp.exp(-t[:, :, None] * jnp.abs(decay.astype(F32))[None])


def bidir_fftconv(u, h):
    n = u.shape[1]
    k = jnp.concatenate([h[:, 0], jnp.zeros_like(h[:1, 1]), jnp.flip(h[1:, 1], 0)], axis=0)
    u_f = jnp.fft.rfft(u, n=2 * n, axis=1)
    k_f = jnp.fft.rfft(k, n=2 * n, axis=0)
    return jnp.fft.irfft(u_f * k_f[None], n=2 * n, axis=1)[:, :n]


def hyena_branch(p, conv_w, conv_b, w1, b1, w2, b2, w3, freq, decay, bias):
    z = short_conv(p.astype(F32), conv_w, conv_b)
    x0, x1, v = jnp.split(z, 3, axis=-1)
    h = hyena_filter(p.shape[1], w1, b1, w2, b2, w3, freq, decay)
    s = x1 * v
    return (x0 * (bidir_fftconv(s, h) + bias.astype(F32) * s)).astype(p.dtype)


def peer_ffn(x, w_q, keys, u_tab, v_tab):
    T = x.shape[0]
    dtype = x.dtype
    keys = keys.astype(F32)
    def block(xt):
        q = (xt @ w_q).astype(F32).reshape(PEER_BLOCK, PEER_HEADS, 2, PEER_DQ // 2)
        s = jnp.einsum('thsd,hskd->thsk', q, keys)
        s1, i1 = lax.top_k(s[:, :, 0], PEER_TOPK)
        s2, i2 = lax.top_k(s[:, :, 1], PEER_TOPK)
        cand = (s1[..., :, None] + s2[..., None, :]).reshape(PEER_BLOCK, PEER_HEADS, PEER_TOPK ** 2)
        cidx = (i1[..., :, None] * PEER_KEYS + i2[..., None, :]).reshape(PEER_BLOCK, PEER_HEADS, PEER_TOPK ** 2)
        top, pos = lax.top_k(cand, PEER_TOPK)
        idx = jnp.take_along_axis(cidx, pos, axis=-1).reshape(PEER_BLOCK, PEER_HEADS * PEER_TOPK)
        gate = jax.nn.softmax(top, axis=-1).reshape(PEER_BLOCK, PEER_HEADS * PEER_TOPK)
        act = jax.nn.gelu(jnp.einsum('td,ted->te', xt, u_tab[idx]).astype(F32))
        return jnp.einsum('te,ted->td', (gate * act).astype(dtype), v_tab[idx])
    out = lax.map(block, x.reshape(T // PEER_BLOCK, PEER_BLOCK, D_MODEL))
    return out.reshape(T, D_MODEL)


def setup_inputs(seed: int = 0) -> dict:
    key = jax.random.key(seed)
    ks = iter(jax.random.split(key, 48))
    nrm = lambda shape, s: s * jax.random.normal(next(ks), shape, F32)
    G, P, Cg = S5_GROUPS, S5_STATE, S5_GROUP
    lo, hi = math.log(S5_DT_MIN), math.log(S5_DT_MAX)
    return {
        'x': nrm((BATCH, SEQ, D_MODEL), 1.0),
        'c': nrm((BATCH, D_MODEL), 1.0),
        'ctx': nrm((BATCH, CTX_LEN, D_MODEL), 1.0),
        'c_ctx': nrm((D_MODEL,), 1.0),
        'w_ada': nrm((DEPTH, D_MODEL, 6 * D_MODEL), 0.5 * D_MODEL ** -0.5),
        'b_ada': nrm((DEPTH, 6 * D_MODEL), 0.01),
        'g_norm1': 1.0 + nrm((DEPTH, D_MODEL), 0.01),
        'g_norm2': 1.0 + nrm((DEPTH, D_MODEL), 0.01),
        'w_in': nrm((DEPTH, D_MODEL, IN_WIDTH), D_MODEL ** -0.5),
        's5_a_re': -0.5 + nrm((DEPTH, 2, G, P), 0.01),
        's5_a_im': math.pi * jnp.arange(P, dtype=F32) + nrm((DEPTH, 2, G, P), 0.01),
        's5_log_step': lo + (hi - lo) * jax.random.uniform(next(ks), (DEPTH, 2, G), F32),
        's5_b_re': nrm((DEPTH, 2, G, P, Cg), (2 * Cg) ** -0.5),
        's5_b_im': nrm((DEPTH, 2, G, P, Cg), (2 * Cg) ** -0.5),
        's5_c_re': nrm((DEPTH, 2, G, Cg, P), P ** -0.5),
        's5_c_im': nrm((DEPTH, 2, G, Cg, P), P ** -0.5),
        's5_d': nrm((DEPTH, D_S5), 1.0),
        's5_w_glu': nrm((DEPTH, D_S5, D_S5), D_S5 ** -0.5),
        's5_b_glu': nrm((DEPTH, D_S5), 0.01),
        'gla_w_alpha': nrm((DEPTH, 2, GLA_RANK, D_GLA_K), GLA_RANK ** -0.5),
        'gla_b_alpha': nrm((DEPTH, 2, D_GLA_K), 0.01),
        'gla_g_norm': 1.0 + nrm((DEPTH, GLA_DV), 0.01),
        'hy_conv_w': nrm((DEPTH, HY_SHORT, 3 * D_HY), HY_SHORT ** -0.5),
        'hy_conv_b': nrm((DEPTH, 3 * D_HY), 0.01),
        'hy_f_w1': nrm((DEPTH, HY_FEAT, HY_HIDDEN), HY_FEAT ** -0.5),
        'hy_f_b1': nrm((DEPTH, HY_HIDDEN), 0.1),
        'hy_f_w2': nrm((DEPTH, HY_HIDDEN, HY_HIDDEN), HY_HIDDEN ** -0.5),
        'hy_f_b2': nrm((DEPTH, HY_HIDDEN), 0.1),
        'hy_f_w3': nrm((DEPTH, HY_HIDDEN, 2 * D_HY), HY_FILTER_SCALE * HY_HIDDEN ** -0.5),
        'hy_f_freq': 1.0 + nrm((DEPTH, 2, HY_HIDDEN), 0.01),
        'hy_decay': jnp.linspace(HY_MIN_DECAY, HY_MAX_DECAY, D_HY, dtype=F32) + nrm((DEPTH, 2, D_HY), 0.01),
        'hy_bias': nrm((DEPTH, D_HY), 1.0),
        'w_out': nrm((DEPTH, D_MIX, D_MODEL), D_MIX ** -0.5),
        'peer_w_q': nrm((DEPTH, D_MODEL, PEER_HEADS * PEER_DQ), D_MODEL ** -0.5),
        'peer_keys': nrm((DEPTH, PEER_HEADS, 2, PEER_KEYS, PEER_DQ // 2), (PEER_DQ // 2) ** -0.5),
        'peer_u': nrm((DEPTH, PEER_EXPERTS, D_MODEL), D_MODEL ** -0.5),
        'peer_v': nrm((DEPTH, PEER_EXPERTS, D_MODEL), 1.0),
        'g_final': 1.0 + nrm((D_MODEL,), 0.01),
    }


def reference(x, c, ctx, c_ctx, w_ada, b_ada, g_norm1, g_norm2, w_in,
              s5_a_re, s5_a_im, s5_log_step, s5_b_re, s5_b_im, s5_c_re, s5_c_im,
              s5_d, s5_w_glu, s5_b_glu, gla_w_alpha, gla_b_alpha, gla_g_norm,
              hy_conv_w, hy_conv_b, hy_f_w1, hy_f_b1, hy_f_w2, hy_f_b2, hy_f_w3,
              hy_f_freq, hy_decay, hy_bias, w_out, peer_w_q, peer_keys, peer_u, peer_v,
              g_final):
    B, L, _ = x.shape
    Lc = ctx.shape[1]
    h_l = x + grid_sincos(L, D_MODEL, x.dtype)[None]
    h_c = ctx
    for l in range(DEPTH):
        last = l == DEPTH - 1
        m_l = (jax.nn.silu(c) @ w_ada[l] + b_ada[l])[:, None, :]
        m_c = (jax.nn.silu(c_ctx) @ w_ada[l] + b_ada[l])[None, None, :]
        sh1_l, sc1_l, gt1_l, sh2_l, sc2_l, gt2_l = jnp.split(m_l, 6, axis=-1)
        sh1_c, sc1_c, gt1_c, sh2_c, sc2_c, gt2_c = jnp.split(m_c, 6, axis=-1)

        p_l = split_in(modulate(h_l, g_norm1[l], sh1_l, sc1_l) @ w_in[l])
        p_c = split_in(modulate(h_c, g_norm1[l], sh1_c, sc1_c) @ w_in[l])
        s5_c, s5_l = s5_mixer(p_c['s5'], p_l['s5'], s5_a_re[l], s5_a_im[l], s5_log_step[l],
                              s5_b_re[l], s5_b_im[l], s5_c_re[l], s5_c_im[l], s5_d[l],
                              s5_w_glu[l], s5_b_glu[l], not last)
        gla_c, gla_l = gla_mixer(p_c, p_l, gla_w_alpha[l], gla_b_alpha[l], gla_g_norm[l], not last)
        hy_args = (hy_conv_w[l], hy_conv_b[l], hy_f_w1[l], hy_f_b1[l], hy_f_w2[l], hy_f_b2[l],
                   hy_f_w3[l], hy_f_freq[l], hy_decay[l], hy_bias[l])
        hy_l = hyena_branch(p_l['hy'], *hy_args)
        h_l = h_l + gt1_l * (jnp.concatenate([s5_l, gla_l, hy_l], axis=-1) @ w_out[l])
        f_in_l = modulate(h_l, g_norm2[l], sh2_l, sc2_l)

        if last:
            f_l = peer_ffn(f_in_l.reshape(B * L, D_MODEL), peer_w_q[l], peer_keys[l], peer_u[l], peer_v[l])
            h_l = h_l + gt2_l * f_l.reshape(B, L, D_MODEL)
        else:
            hy_c = hyena_branch(p_c['hy'], *hy_args)
            h_c = h_c + gt1_c * (jnp.concatenate([s5_c, gla_c, hy_c], axis=-1) @ w_out[l])
            f_in_c = modulate(h_c, g_norm2[l], sh2_c, sc2_c)
            tok = jnp.concatenate([f_in_c, f_in_l], axis=1).reshape(B * (Lc + L), D_MODEL)
            f = peer_ffn(tok, peer_w_q[l], peer_keys[l], peer_u[l], peer_v[l]).reshape(B, Lc + L, D_MODEL)
            h_c = h_c + gt2_c * f[:, :Lc]
            h_l = h_l + gt2_l * f[:, Lc:]
    return rmsnorm(h_l, g_final)
```

```cpp
#include <hip/hip_runtime.h>
#include <math.h>
#include <stdint.h>

constexpr int D = 2048, SEQ = 8192, CTX = 256, T = SEQ + CTX, DEPTH = 4;
constexpr int DS5 = 512, G5 = 32, CG = 16, PS = 64;
constexpr int GH = 4, DK = 128, DV = 256, DGK = 512, DGV = 1024, RANK = 16;
constexpr int DHY = 512, HYF = 33, HYH = 64;
constexpr int INW = 5152;
constexpr int O_S5 = 0, O_Q = 512, O_K = 1024, O_V = 1536, O_GATE = 2560, O_ALPHA = 3584, O_HY = 3616;
constexpr int PH = 8, PKEYS = 128, PDQ = 256, PTOP = 16, PEXP = 16384;
constexpr float EPS = 1e-6f;

__device__ __forceinline__ float gelu_f(float x) {
    return 0.5f * x * (1.f + tanhf(0.7978845608028654f * (x + 0.044715f * x * x * x)));
}
__device__ __forceinline__ float sigmoid_f(float x) { return 1.f / (1.f + expf(-x)); }
__device__ __forceinline__ float silu_f(float x) { return x * sigmoid_f(x); }
__device__ __forceinline__ float logsigmoid_f(float x) { return fminf(x, 0.f) - log1pf(expf(-fabsf(x))); }

__device__ __forceinline__ float wave_sum(float v) {
#pragma unroll
    for (int o = 32; o > 0; o >>= 1) v += __shfl_xor(v, o);
    return v;
}
__device__ __forceinline__ float block_sum256(float v, float* red) {
    v = wave_sum(v);
    __syncthreads();
    if ((threadIdx.x & 63) == 0) red[threadIdx.x >> 6] = v;
    __syncthreads();
    return red[0] + red[1] + red[2] + red[3];
}

__device__ __forceinline__ int scan_row(int dr, int j) {
    return dr == 0 ? j : (j < CTX ? CTX - 1 - j : (T + CTX - 1) - j);
}

__global__ void k_init_h(const float* __restrict__ x, const float* __restrict__ ctx, float* __restrict__ H) {
    int row = blockIdx.x;
    for (int d = threadIdx.x; d < D; d += 256) {
        float v;
        if (row < CTX) v = ctx[(size_t)row * D + d];
        else {
            int t = row - CTX;
            int r = t / 64, c = t % 64;
            int q = d / 512, i = d % 512;
            float omega = 1.0f / powf(10000.0f, (float)i / 512.0f);
            float p = (q < 2) ? (float)r : (float)c;
            float a = p * omega;
            float pe = (q & 1) ? cosf(a) : sinf(a);
            v = x[(size_t)t * D + d] + pe;
        }
        H[(size_t)row * D + d] = v;
    }
}

__global__ void k_ada(const float* __restrict__ c, const float* __restrict__ cctx, const float* __restrict__ w_ada,
                      const float* __restrict__ b_ada, float* __restrict__ MOD) {
    __shared__ float s0[D], s1[D];
    int l = blockIdx.y;
    for (int i = threadIdx.x; i < D; i += 256) { s0[i] = silu_f(c[i]); s1[i] = silu_f(cctx[i]); }
    __syncthreads();
    int j = blockIdx.x * 256 + threadIdx.x;
    const float* w = w_ada + (size_t)l * D * 6 * D + j;
    float a0 = 0.f, a1 = 0.f;
    for (int i = 0; i < D; ++i) { float wv = w[(size_t)i * 6 * D]; a0 += s0[i] * wv; a1 += s1[i] * wv; }
    float b = b_ada[(size_t)l * 6 * D + j];
    MOD[((size_t)l * 2 + 0) * 6 * D + j] = a0 + b;
    MOD[((size_t)l * 2 + 1) * 6 * D + j] = a1 + b;
}

__global__ void k_modulate(const float* __restrict__ H, const float* __restrict__ g, const float* __restrict__ MODl,
                           int shift_off, int scale_off, float* __restrict__ OUT) {
    __shared__ float red[4];
    int row = blockIdx.x;
    const float* h = H + (size_t)row * D;
    float ss = 0.f;
    for (int d = threadIdx.x; d < D; d += 256) { float v = h[d]; ss += v * v; }
    ss = block_sum256(ss, red);
    float rs = rsqrtf(ss / D + EPS);
    const float* m = MODl + (size_t)(row < CTX ? 1 : 0) * 6 * D;
    for (int d = threadIdx.x; d < D; d += 256)
        OUT[(size_t)row * D + d] = h[d] * rs * g[d] * (1.f + m[scale_off + d]) + m[shift_off + d];
}

template <int EPI>
__global__ void k_gemm(const float* __restrict__ A, int lda, const float* __restrict__ W, int ldw,
                       float* __restrict__ C, int ldc, int M, int N, int K, const float* __restrict__ MODl, int gate_off) {
    __shared__ float As[16][64 + 4];
    __shared__ float Bs[16][64 + 4];
    int bm = blockIdx.y * 64, bn = blockIdx.x * 64;
    int tx = threadIdx.x % 16, ty = threadIdx.x / 16;
    float acc[4][4] = {};
    for (int k0 = 0; k0 < K; k0 += 16) {
        for (int e = threadIdx.x; e < 64 * 16; e += 256) {
            int r = e / 16, kk = e % 16;
            As[kk][r] = A[(size_t)(bm + r) * lda + k0 + kk];
        }
        for (int e = threadIdx.x; e < 16 * 64; e += 256) {
            int kk = e / 64, cidx = e % 64;
            int n = bn + cidx;
            Bs[kk][cidx] = (n < N) ? W[(size_t)(k0 + kk) * ldw + n] : 0.f;
        }
        __syncthreads();
#pragma unroll
        for (int kk = 0; kk < 16; ++kk) {
            float a[4], b[4];
#pragma unroll
            for (int i = 0; i < 4; ++i) { a[i] = As[kk][ty * 4 + i]; b[i] = Bs[kk][tx * 4 + i]; }
#pragma unroll
            for (int i = 0; i < 4; ++i)
#pragma unroll
                for (int j = 0; j < 4; ++j) acc[i][j] += a[i] * b[j];
        }
        __syncthreads();
    }
#pragma unroll
    for (int i = 0; i < 4; ++i)
#pragma unroll
        for (int j = 0; j < 4; ++j) {
            int m = bm + ty * 4 + i, n = bn + tx * 4 + j;
            if (n < N) {
                if (EPI == 0) C[(size_t)m * ldc + n] = acc[i][j];
                else {
                    float gt = MODl[(size_t)(m < CTX ? 1 : 0) * 6 * D + gate_off + n];
                    C[(size_t)m * ldc + n] += gt * acc[i][j];
                }
            }
        }
}

__global__ void k_s5_scan(const float* __restrict__ P, const float* __restrict__ a_re, const float* __restrict__ a_im,
                          const float* __restrict__ log_step, const float* __restrict__ b_re, const float* __restrict__ b_im,
                          const float* __restrict__ c_re, const float* __restrict__ c_im, float* __restrict__ Y  ) {
    __shared__ float sh_hr[PS], sh_hi[PS];
    __shared__ float sh_cr[CG][PS], sh_ci[CG][PS];
    int g = blockIdx.x, dr = blockIdx.y, p = threadIdx.x;
    size_t gp = ((size_t)dr * G5 + g) * PS + p;
    float ar = a_re[gp], ai = a_im[gp];
    float dt = expf(log_step[(size_t)dr * G5 + g]);
    float er = expf(ar * dt);
    float lbr = er * cosf(ai * dt), lbi = er * sinf(ai * dt);
    float nr = lbr - 1.f, ni = lbi, den = ar * ar + ai * ai;
    float cfr = (nr * ar + ni * ai) / den, cfi = (ni * ar - nr * ai) / den;
    float bbr[CG], bbi[CG];
#pragma unroll
    for (int c = 0; c < CG; ++c) {
        float br = b_re[gp * CG + c], bi = b_im[gp * CG + c];
        bbr[c] = cfr * br - cfi * bi;
        bbi[c] = cfr * bi + cfi * br;
    }
    for (int c = 0; c < CG; ++c) {
        size_t ci = (((size_t)dr * G5 + g) * CG + c) * PS + p;
        sh_cr[c][p] = c_re[ci];
        sh_ci[c][p] = c_im[ci];
    }
    __syncthreads();
    float hr = 0.f, hi = 0.f;
    int c_out = p & 15, part = p >> 4;
    for (int j = 0; j < T; ++j) {
        int row = scan_row(dr, j);
        const float* u = P + (size_t)row * INW + O_S5 + g * CG;
        float bur = 0.f, bui = 0.f;
#pragma unroll
        for (int c = 0; c < CG; ++c) { float uv = u[c]; bur += uv * bbr[c]; bui += uv * bbi[c]; }
        float nhr = lbr * hr - lbi * hi + bur;
        float nhi = lbr * hi + lbi * hr + bui;
        hr = nhr; hi = nhi;
        __syncthreads();
        sh_hr[p] = hr; sh_hi[p] = hi;
        __syncthreads();
        float acc = 0.f;
#pragma unroll
        for (int q = 0; q < 16; ++q) {
            int pp = part * 16 + q;
            acc += sh_hr[pp] * sh_cr[c_out][pp] - sh_hi[pp] * sh_ci[c_out][pp];
        }
        acc += __shfl_xor(acc, 16);
        acc += __shfl_xor(acc, 32);
        if (part == 0) Y[((size_t)dr * T + row) * DS5 + g * CG + c_out] = acc;
    }
}

__global__ void k_s5_finish(const float* __restrict__ P, const float* __restrict__ Y, const float* __restrict__ d,
                            float* __restrict__ Z) {
    size_t i = (size_t)blockIdx.x * 256 + threadIdx.x;
    int row = i / DS5, ch = i % DS5;
    float u = P[(size_t)row * INW + O_S5 + ch];
    float y = Y[i] + Y[(size_t)T * DS5 + i] + d[ch] * u;
    Z[i] = gelu_f(y);
}
__global__ void k_s5_glu(const float* __restrict__ Z, const float* __restrict__ ZG, const float* __restrict__ b,
                         float* __restrict__ MIX) {
    size_t i = (size_t)blockIdx.x * 256 + threadIdx.x;
    int row = i / DS5, ch = i % DS5;
    MIX[(size_t)row * D + ch] = Z[i] * sigmoid_f(ZG[i] + b[ch]);
}

__global__ void k_gla_gate(const float* __restrict__ P, const float* __restrict__ w_alpha, const float* __restrict__ b_alpha,
                           float* __restrict__ G  ) {
    size_t i = (size_t)blockIdx.x * 256 + threadIdx.x;
    int j = i % DGK;
    int row = (i / DGK) % T;
    int dr = i / ((size_t)DGK * T);
    const float* lr = P + (size_t)row * INW + O_ALPHA + dr * RANK;
    float acc = b_alpha[dr * DGK + j];
#pragma unroll
    for (int r = 0; r < RANK; ++r) acc += lr[r] * w_alpha[((size_t)dr * RANK + r) * DGK + j];
    G[i] = logsigmoid_f(acc) * (1.f / 16.f);
}

__global__ void __launch_bounds__(256) k_gla_scan(const float* __restrict__ P, const float* __restrict__ G,
                                                   float* __restrict__ O  ) {
    __shared__ float s_q[DK], s_k[DK], s_e[DK];
    int head = blockIdx.x, dr = blockIdx.y, v = threadIdx.x;
    float S[DK];
#pragma unroll
    for (int k = 0; k < DK; ++k) S[k] = 0.f;
    const float qscale = 0.08838834764831845f;
    for (int j = 0; j < T; ++j) {
        int row = scan_row(dr, j);
        const float* pr = P + (size_t)row * INW;
        if (v < DK) {
            s_q[v] = pr[O_Q + head * DK + v] * qscale;
            s_k[v] = pr[O_K + head * DK + v];
            s_e[v] = expf(G[((size_t)dr * T + row) * DGK + head * DK + v]);
        }
        float vv = pr[O_V + head * DV + v];
        __syncthreads();
        float o = 0.f;
#pragma unroll
        for (int k = 0; k < DK; ++k) {
            S[k] = s_e[k] * S[k] + s_k[k] * vv;
            o += s_q[k] * S[k];
        }
        O[((size_t)dr * T + row) * DGV + head * DV + v] = o;
        __syncthreads();
    }
}

__global__ void k_gla_finish(const float* __restrict__ P, const float* __restrict__ O, const float* __restrict__ gn,
                             float* __restrict__ MIX) {
    __shared__ float red[4];
    int row = blockIdx.x, head = blockIdx.y, v = threadIdx.x;
    size_t i = (size_t)row * DGV + head * DV + v;
    float o = O[i] + O[(size_t)T * DGV + i];
    float ss = block_sum256(o * o, red);
    float rs = rsqrtf(ss / DV + EPS);
    float gate = P[(size_t)row * INW + O_GATE + head * DV + v];
    MIX[(size_t)row * D + DS5 + head * DV + v] = o * rs * gn[v] * silu_f(gate);
}

__global__ void k_hy_filter1(int n, const float* __restrict__ w1, const float* __restrict__ b1, const float* __restrict__ w2,
                             const float* __restrict__ b2, const float* __restrict__ freq, float* __restrict__ H2  ) {
    __shared__ float z[HYF], h1[HYH];
    int t = blockIdx.x, m = threadIdx.x;
    if (m < HYF) {
        float tn = (float)t / (float)(n - 1);
        float w = 2.0f * 3.14159265358979323846f * (float)t / (float)n;
        float val;
        if (m == 0) val = tn;
        else {
            int b = (m - 1) % 16;
            float band = 1e-4f + (float)b * ((15.0f - 1e-4f) / 15.0f);
            val = (m <= 16) ? cosf(band * w) : -sinf(band * w);
        }
        z[m] = val;
    }
    __syncthreads();
    float acc = b1[m];
    for (int f = 0; f < HYF; ++f) acc += z[f] * w1[f * HYH + m];
    h1[m] = sinf(freq[m] * acc);
    __syncthreads();
    float acc2 = b2[m];
    for (int k = 0; k < HYH; ++k) acc2 += h1[k] * w2[k * HYH + m];
    H2[(size_t)t * HYH + m] = sinf(freq[HYH + m] * acc2);
}
__global__ void k_hy_filter2(int n, const float* __restrict__ H2, const float* __restrict__ w3, const float* __restrict__ decay,
                             float* __restrict__ FILT) {
    size_t i = (size_t)blockIdx.x * 256 + threadIdx.x;
    int j = i % 1024, t = i / 1024;
    float acc = 0.f;
    for (int m = 0; m < HYH; ++m) acc += H2[(size_t)t * HYH + m] * w3[m * 1024 + j];
    float tn = (float)t / (float)(n - 1);
    FILT[i] = acc * expf(-tn * fabsf(decay[j]));
}
__global__ void k_hy_shortconv(const float* __restrict__ P, const float* __restrict__ cw, const float* __restrict__ cb,
                               float* __restrict__ ZC  ) {
    size_t i = (size_t)blockIdx.x * 256 + threadIdx.x;
    int c = i % 1536, row = i / 1536;
    int base = row < CTX ? 0 : CTX, n = row < CTX ? CTX : SEQ, li = row - base;
    float acc = cb[c];
#pragma unroll
    for (int j = 0; j < 3; ++j) {
        int s = li + j - 1;
        if (s >= 0 && s < n) acc += cw[j * 1536 + c] * P[(size_t)(base + s) * INW + O_HY + c];
    }
    ZC[i] = acc;
}
__global__ void k_hy_conv(const float* __restrict__ ZC, const float* __restrict__ FL, const float* __restrict__ FC,
                          const float* __restrict__ bias, float* __restrict__ MIX) {
    int c = blockIdx.x * 64 + (threadIdx.x & 63);
    int row = blockIdx.y * 4 + (threadIdx.x >> 6);
    int base = row < CTX ? 0 : CTX, n = row < CTX ? CTX : SEQ, li = row - base;
    const float* F = row < CTX ? FC : FL;
    float acc = 0.f;
    for (int s = 0; s < n; ++s) {
        const float* zr = ZC + (size_t)(base + s) * 1536;
        float sv = zr[512 + c] * zr[1024 + c];
        float f = (li >= s) ? F[(size_t)(li - s) * 1024 + c] : F[(size_t)(s - li) * 1024 + 512 + c];
        acc += f * sv;
    }
    const float* zr = ZC + (size_t)row * 1536;
    float si = zr[512 + c] * zr[1024 + c];
    MIX[(size_t)row * D + 1536 + c] = zr[c] * (acc + bias[c] * si);
}

__global__ void __launch_bounds__(64) k_peer_select(const float* __restrict__ Q, const float* __restrict__ keys  ,
                                                     int* __restrict__ IDX, float* __restrict__ GATE) {
    __shared__ float sc[64][257];
    int tok = blockIdx.x * 64 + threadIdx.x, h = blockIdx.y;
    const float* q = Q + (size_t)tok * D + h * PDQ;
    for (int s = 0; s < 2; ++s) {
        float qr[128];
#pragma unroll
        for (int d = 0; d < 128; ++d) qr[d] = q[s * 128 + d];
        const float* kb = keys + ((size_t)h * 2 + s) * PKEYS * 128;
        for (int k = 0; k < PKEYS; ++k) {
            float acc = 0.f;
#pragma unroll
            for (int d = 0; d < 128; ++d) acc += qr[d] * kb[k * 128 + d];
            sc[threadIdx.x][s * 128 + k] = acc;
        }
    }
    float tv[2][16]; int ti[2][16];
#pragma unroll
    for (int s = 0; s < 2; ++s)
#pragma unroll
        for (int j = 0; j < 16; ++j) { tv[s][j] = -INFINITY; ti[s][j] = 0; }
#pragma unroll
    for (int s = 0; s < 2; ++s) {
        for (int k = 0; k < PKEYS; ++k) {
            float c = sc[threadIdx.x][s * 128 + k]; int ci = k;
#pragma unroll
            for (int j = 0; j < 16; ++j) {
                bool gt = c > tv[s][j];
                float tvv = tv[s][j]; int tii = ti[s][j];
                tv[s][j] = gt ? c : tvv; ti[s][j] = gt ? ci : tii;
                c = gt ? tvv : c; ci = gt ? tii : ci;
            }
        }
    }
    float cv[16]; int cx[16];
#pragma unroll
    for (int j = 0; j < 16; ++j) { cv[j] = -INFINITY; cx[j] = 0; }
#pragma unroll
    for (int a = 0; a < 16; ++a)
#pragma unroll
        for (int b = 0; b < 16; ++b) {
            float c = tv[0][a] + tv[1][b]; int ci = ti[0][a] * PKEYS + ti[1][b];
#pragma unroll
            for (int j = 0; j < 16; ++j) {
                bool gt = c > cv[j];
                float tvv = cv[j]; int tii = cx[j];
                cv[j] = gt ? c : tvv; cx[j] = gt ? ci : tii;
                c = gt ? tvv : c; ci = gt ? tii : ci;
            }
        }
    float mx = cv[0], sum = 0.f, e[16];
#pragma unroll
    for (int j = 0; j < 16; ++j) { e[j] = expf(cv[j] - mx); sum += e[j]; }
    float inv = 1.f / sum;
#pragma unroll
    for (int j = 0; j < 16; ++j) {
        IDX[(size_t)tok * 128 + h * 16 + j] = cx[j];
        GATE[(size_t)tok * 128 + h * 16 + j] = e[j] * inv;
    }
}

__global__ void __launch_bounds__(256) k_peer_expert(const float* __restrict__ X, const int* __restrict__ IDX,
                                                      const float* __restrict__ GATE, const float* __restrict__ U,
                                                      const float* __restrict__ V, const float* __restrict__ MODl,
                                                      float* __restrict__ H) {
    __shared__ float wgt[128];
    __shared__ int eidx[128];
    int tok = blockIdx.x, tid = threadIdx.x, lane = tid & 63, w = tid >> 6;
    if (tid < 128) eidx[tid] = IDX[(size_t)tok * 128 + tid];
    const float* x = X + (size_t)tok * D;
    float4 xr[8];
#pragma unroll
    for (int i = 0; i < 8; ++i) xr[i] = *reinterpret_cast<const float4*>(x + i * 256 + lane * 4);
    __syncthreads();
    for (int e = w * 32; e < w * 32 + 32; ++e) {
        const float* ur = U + (size_t)eidx[e] * D;
        float acc = 0.f;
#pragma unroll
        for (int i = 0; i < 8; ++i) {
            float4 uv = *reinterpret_cast<const float4*>(ur + i * 256 + lane * 4);
            acc += xr[i].x * uv.x + xr[i].y * uv.y + xr[i].z * uv.z + xr[i].w * uv.w;
        }
        acc = wave_sum(acc);
        if (lane == 0) wgt[e] = GATE[(size_t)tok * 128 + e] * gelu_f(acc);
    }
    __syncthreads();
    float4 o0 = {0, 0, 0, 0}, o1 = {0, 0, 0, 0};
    for (int e = 0; e < 128; ++e) {
        const float* vr = V + (size_t)eidx[e] * D;
        float wg = wgt[e];
        float4 a = *reinterpret_cast<const float4*>(vr + tid * 4);
        float4 b = *reinterpret_cast<const float4*>(vr + 1024 + tid * 4);
        o0.x += wg * a.x; o0.y += wg * a.y; o0.z += wg * a.z; o0.w += wg * a.w;
        o1.x += wg * b.x; o1.y += wg * b.y; o1.z += wg * b.z; o1.w += wg * b.w;
    }
    const float* gt = MODl + (size_t)(tok < CTX ? 1 : 0) * 6 * D + 5 * D;
    float* h = H + (size_t)tok * D;
    int d0 = tid * 4, d1 = 1024 + tid * 4;
    h[d0 + 0] += gt[d0 + 0] * o0.x; h[d0 + 1] += gt[d0 + 1] * o0.y; h[d0 + 2] += gt[d0 + 2] * o0.z; h[d0 + 3] += gt[d0 + 3] * o0.w;
    h[d1 + 0] += gt[d1 + 0] * o1.x; h[d1 + 1] += gt[d1 + 1] * o1.y; h[d1 + 2] += gt[d1 + 2] * o1.z; h[d1 + 3] += gt[d1 + 3] * o1.w;
}

__global__ void k_final(const float* __restrict__ H, const float* __restrict__ g, float* __restrict__ out) {
    __shared__ float red[4];
    int t = blockIdx.x;
    const float* h = H + (size_t)(CTX + t) * D;
    float ss = 0.f;
    for (int d = threadIdx.x; d < D; d += 256) { float v = h[d]; ss += v * v; }
    ss = block_sum256(ss, red);
    float rs = rsqrtf(ss / D + EPS);
    for (int d = threadIdx.x; d < D; d += 256) out[(size_t)t * D + d] = h[d] * rs * g[d];
}

extern "C" void kernel_launch(void* const* d_in, const int* in_sizes, int n_in, void* d_out, int out_size, void* d_ws,
                              size_t ws_size, hipStream_t stream) {
    const float* x = (const float*)d_in[0];
    const float* c = (const float*)d_in[1];
    const float* ctx = (const float*)d_in[2];
    const float* c_ctx = (const float*)d_in[3];
    const float* w_ada = (const float*)d_in[4];
    const float* b_ada = (const float*)d_in[5];
    const float* g_norm1 = (const float*)d_in[6];
    const float* g_norm2 = (const float*)d_in[7];
    const float* w_in = (const float*)d_in[8];
    const float* s5_a_re = (const float*)d_in[9];
    const float* s5_a_im = (const float*)d_in[10];
    const float* s5_log_step = (const float*)d_in[11];
    const float* s5_b_re = (const float*)d_in[12];
    const float* s5_b_im = (const float*)d_in[13];
    const float* s5_c_re = (const float*)d_in[14];
    const float* s5_c_im = (const float*)d_in[15];
    const float* s5_d = (const float*)d_in[16];
    const float* s5_w_glu = (const float*)d_in[17];
    const float* s5_b_glu = (const float*)d_in[18];
    const float* gla_w_alpha = (const float*)d_in[19];
    const float* gla_b_alpha = (const float*)d_in[20];
    const float* gla_g_norm = (const float*)d_in[21];
    const float* hy_conv_w = (const float*)d_in[22];
    const float* hy_conv_b = (const float*)d_in[23];
    const float* hy_f_w1 = (const float*)d_in[24];
    const float* hy_f_b1 = (const float*)d_in[25];
    const float* hy_f_w2 = (const float*)d_in[26];
    const float* hy_f_b2 = (const float*)d_in[27];
    const float* hy_f_w3 = (const float*)d_in[28];
    const float* hy_f_freq = (const float*)d_in[29];
    const float* hy_decay = (const float*)d_in[30];
    const float* hy_bias = (const float*)d_in[31];
    const float* w_out = (const float*)d_in[32];
    const float* peer_w_q = (const float*)d_in[33];
    const float* peer_keys = (const float*)d_in[34];
    const float* peer_u = (const float*)d_in[35];
    const float* peer_v = (const float*)d_in[36];
    const float* g_final = (const float*)d_in[37];
    float* out = (float*)d_out;

    char* wp = (char*)d_ws;
    auto alloc = [&](size_t bytes) { char* r = wp; wp += (bytes + 255) & ~(size_t)255; return r; };
    float* H = (float*)alloc((size_t)T * D * 4);
    float* MOD = (float*)alloc((size_t)DEPTH * 2 * 6 * D * 4);
    float* A1 = (float*)alloc((size_t)T * D * 4);
    float* P = (float*)alloc((size_t)T * INW * 4);
    float* Y = (float*)alloc((size_t)2 * T * DS5 * 4);
    float* Z = (float*)alloc((size_t)T * DS5 * 4);
    float* ZG = (float*)alloc((size_t)T * DS5 * 4);
    float* GG = (float*)alloc((size_t)2 * T * DGK * 4);
    float* O = (float*)alloc((size_t)2 * T * DGV * 4);
    float* ZC = (float*)alloc((size_t)T * 1536 * 4);
    float* H2 = (float*)alloc((size_t)SEQ * HYH * 4);
    float* FL = (float*)alloc((size_t)SEQ * 1024 * 4);
    float* FC = (float*)alloc((size_t)CTX * 1024 * 4);
    float* MIX = (float*)alloc((size_t)T * D * 4);
    float* Q = (float*)alloc((size_t)T * D * 4);
    int* IDX = (int*)alloc((size_t)T * 128 * 4);
    float* GATE = (float*)alloc((size_t)T * 128 * 4);

    k_init_h<<<T, 256, 0, stream>>>(x, ctx, H);
    k_ada<<<dim3(6 * D / 256, DEPTH), 256, 0, stream>>>(c, c_ctx, w_ada, b_ada, MOD);

    for (int l = 0; l < DEPTH; ++l) {
        const float* MODl = MOD + (size_t)l * 2 * 6 * D;
        k_modulate<<<T, 256, 0, stream>>>(H, g_norm1 + (size_t)l * D, MODl, 0, D, A1);
        k_gemm<0><<<dim3((INW + 63) / 64, T / 64), 256, 0, stream>>>(A1, D, w_in + (size_t)l * D * INW, INW, P, INW, T, INW, D,
                                                                     nullptr, 0);
        k_s5_scan<<<dim3(G5, 2), 64, 0, stream>>>(P, s5_a_re + (size_t)l * 2 * G5 * PS, s5_a_im + (size_t)l * 2 * G5 * PS,
                                                  s5_log_step + (size_t)l * 2 * G5, s5_b_re + (size_t)l * 2 * G5 * PS * CG,
                                                  s5_b_im + (size_t)l * 2 * G5 * PS * CG, s5_c_re + (size_t)l * 2 * G5 * CG * PS,
                                                  s5_c_im + (size_t)l * 2 * G5 * CG * PS, Y);
        k_s5_finish<<<T * DS5 / 256, 256, 0, stream>>>(P, Y, s5_d + (size_t)l * DS5, Z);
        k_gemm<0><<<dim3(DS5 / 64, T / 64), 256, 0, stream>>>(Z, DS5, s5_w_glu + (size_t)l * DS5 * DS5, DS5, ZG, DS5, T, DS5,
                                                              DS5, nullptr, 0);
        k_s5_glu<<<T * DS5 / 256, 256, 0, stream>>>(Z, ZG, s5_b_glu + (size_t)l * DS5, MIX);
        k_gla_gate<<<2 * T * DGK / 256, 256, 0, stream>>>(P, gla_w_alpha + (size_t)l * 2 * RANK * DGK,
                                                          gla_b_alpha + (size_t)l * 2 * DGK, GG);
        k_gla_scan<<<dim3(GH, 2), 256, 0, stream>>>(P, GG, O);
        k_gla_finish<<<dim3(T, GH), 256, 0, stream>>>(P, O, gla_g_norm + (size_t)l * DV, MIX);
        k_hy_filter1<<<SEQ, 64, 0, stream>>>(SEQ, hy_f_w1 + (size_t)l * HYF * HYH, hy_f_b1 + (size_t)l * HYH,
                                             hy_f_w2 + (size_t)l * HYH * HYH, hy_f_b2 + (size_t)l * HYH,
                                             hy_f_freq + (size_t)l * 2 * HYH, H2);
        k_hy_filter2<<<SEQ * 1024 / 256, 256, 0, stream>>>(SEQ, H2, hy_f_w3 + (size_t)l * HYH * 1024,
                                                           hy_decay + (size_t)l * 2 * DHY, FL);
        k_hy_filter1<<<CTX, 64, 0, stream>>>(CTX, hy_f_w1 + (size_t)l * HYF * HYH, hy_f_b1 + (size_t)l * HYH,
                                             hy_f_w2 + (size_t)l * HYH * HYH, hy_f_b2 + (size_t)l * HYH,
                                             hy_f_freq + (size_t)l * 2 * HYH, H2);
        k_hy_filter2<<<CTX * 1024 / 256, 256, 0, stream>>>(CTX, H2, hy_f_w3 + (size_t)l * HYH * 1024,
                                                           hy_decay + (size_t)l * 2 * DHY, FC);
        k_hy_shortconv<<<T * 1536 / 256, 256, 0, stream>>>(P, hy_conv_w + (size_t)l * 3 * 1536, hy_conv_b + (size_t)l * 1536, ZC);
        k_hy_conv<<<dim3(DHY / 64, T / 4), 256, 0, stream>>>(ZC, FL, FC, hy_bias + (size_t)l * DHY, MIX);
        k_gemm<1><<<dim3(D / 64, T / 64), 256, 0, stream>>>(MIX, D, w_out + (size_t)l * D * D, D, H, D, T, D, D, MODl, 2 * D);
        k_modulate<<<T, 256, 0, stream>>>(H, g_norm2 + (size_t)l * D, MODl, 3 * D, 4 * D, A1);
        k_gemm<0><<<dim3(D / 64, T / 64), 256, 0, stream>>>(A1, D, peer_w_q + (size_t)l * D * D, D, Q, D, T, D, D, nullptr, 0);
        k_peer_select<<<dim3(T / 64, PH), 64, 0, stream>>>(Q, peer_keys + (size_t)l * PH * 2 * PKEYS * 128, IDX, GATE);
        k_peer_expert<<<T, 256, 0, stream>>>(A1, IDX, GATE, peer_u + (size_t)l * PEXP * D, peer_v + (size_t)l * PEXP * D, MODl, H);
    }
    k_final<<<SEQ, 256, 0, stream>>>(H, g_final, out);
}
```

```cpp
#include <hip/hip_runtime.h>
#include <math.h>
#include <stdint.h>
#include <stdio.h>

constexpr int D = 2048, SEQ = 8192, CTX = 256, T = SEQ + CTX, DEPTH = 4;
constexpr int DS5 = 512, G5 = 32, CG = 16, PS = 64;
constexpr int GH = 4, DK = 128, DV = 256, DGK = 512, DGV = 1024, RANK = 16;
constexpr int DHY = 512, HYF = 33, HYH = 64;
constexpr int INW = 5152;
constexpr int O_S5 = 0, O_Q = 512, O_K = 1024, O_V = 1536, O_GATE = 2560, O_ALPHA = 3584, O_HY = 3616;
constexpr int PH = 8, PKEYS = 128, PDQ = 256, PTOP = 16, PEXP = 16384;
constexpr float EPS = 1e-6f;

__device__ __forceinline__ float gelu_f(float x) {
    return 0.5f * x * (1.f + tanhf(0.7978845608028654f * (x + 0.044715f * x * x * x)));
}
__device__ __forceinline__ float sigmoid_f(float x) { return 1.f / (1.f + expf(-x)); }
__device__ __forceinline__ float silu_f(float x) { return x * sigmoid_f(x); }
__device__ __forceinline__ float logsigmoid_f(float x) { return fminf(x, 0.f) - log1pf(expf(-fabsf(x))); }

__device__ __forceinline__ float wave_sum(float v) {
#pragma unroll
    for (int o = 32; o > 0; o >>= 1) v += __shfl_xor(v, o);
    return v;
}
__device__ __forceinline__ float block_sum256(float v, float* red) {
    v = wave_sum(v);
    __syncthreads();
    if ((threadIdx.x & 63) == 0) red[threadIdx.x >> 6] = v;
    __syncthreads();
    return red[0] + red[1] + red[2] + red[3];
}

__device__ __forceinline__ int scan_row(int dr, int j) {
    return dr == 0 ? j : (j < CTX ? CTX - 1 - j : (T + CTX - 1) - j);
}

__global__ void k_init_h(const float* __restrict__ x, const float* __restrict__ ctx, float* __restrict__ H) {
    int row = blockIdx.x;
    for (int d = threadIdx.x; d < D; d += 256) {
        float v;
        if (row < CTX) v = ctx[(size_t)row * D + d];
        else {
            int t = row - CTX;
            int r = t / 64, c = t % 64;
            int q = d / 512, i = d % 512;
            float omega = 1.0f / powf(10000.0f, (float)i / 512.0f);
            float p = (q < 2) ? (float)r : (float)c;
            float a = p * omega;
            float pe = (q & 1) ? cosf(a) : sinf(a);
            v = x[(size_t)t * D + d] + pe;
        }
        H[(size_t)row * D + d] = v;
    }
}

__global__ void k_ada(const float* __restrict__ c, const float* __restrict__ cctx, const float* __restrict__ w_ada,
                      const float* __restrict__ b_ada, float* __restrict__ MOD) {
    __shared__ float s0[D], s1[D];
    int l = blockIdx.y;
    for (int i = threadIdx.x; i < D; i += 256) { s0[i] = silu_f(c[i]); s1[i] = silu_f(cctx[i]); }
    __syncthreads();
    int j = blockIdx.x * 256 + threadIdx.x;
    const float* w = w_ada + (size_t)l * D * 6 * D + j;
    float a0 = 0.f, a1 = 0.f;
    for (int i = 0; i < D; ++i) { float wv = w[(size_t)i * 6 * D]; a0 += s0[i] * wv; a1 += s1[i] * wv; }
    float b = b_ada[(size_t)l * 6 * D + j];
    MOD[((size_t)l * 2 + 0) * 6 * D + j] = a0 + b;
    MOD[((size_t)l * 2 + 1) * 6 * D + j] = a1 + b;
}

__global__ void k_modulate(const float* __restrict__ H, const float* __restrict__ g, const float* __restrict__ MODl,
                           int shift_off, int scale_off, float* __restrict__ OUT) {
    __shared__ float red[4];
    int row = blockIdx.x;
    const float* h = H + (size_t)row * D;
    float ss = 0.f;
    for (int d = threadIdx.x; d < D; d += 256) { float v = h[d]; ss += v * v; }
    ss = block_sum256(ss, red);
    float rs = rsqrtf(ss / D + EPS);
    const float* m = MODl + (size_t)(row < CTX ? 1 : 0) * 6 * D;
    for (int d = threadIdx.x; d < D; d += 256)
        OUT[(size_t)row * D + d] = h[d] * rs * g[d] * (1.f + m[scale_off + d]) + m[shift_off + d];
}

template <int EPI>
__global__ void k_gemm(const float* __restrict__ A, int lda, const float* __restrict__ W, int ldw,
                       float* __restrict__ C, int ldc, int M, int N, int K, const float* __restrict__ MODl, int gate_off) {
    __shared__ float As[16][64 + 4];
    __shared__ float Bs[16][64 + 4];
    int bm = blockIdx.y * 64, bn = blockIdx.x * 64;
    int tx = threadIdx.x % 16, ty = threadIdx.x / 16;
    float acc[4][4] = {};
    for (int k0 = 0; k0 < K; k0 += 16) {
        for (int e = threadIdx.x; e < 64 * 16; e += 256) {
            int r = e / 16, kk = e % 16;
            As[kk][r] = A[(size_t)(bm + r) * lda + k0 + kk];
        }
        for (int e = threadIdx.x; e < 16 * 64; e += 256) {
            int kk = e / 64, cidx = e % 64;
            int n = bn + cidx;
            Bs[kk][cidx] = (n < N) ? W[(size_t)(k0 + kk) * ldw + n] : 0.f;
        }
        __syncthreads();
#pragma unroll
        for (int kk = 0; kk < 16; ++kk) {
            float a[4], b[4];
#pragma unroll
            for (int i = 0; i < 4; ++i) { a[i] = As[kk][ty * 4 + i]; b[i] = Bs[kk][tx * 4 + i]; }
#pragma unroll
            for (int i = 0; i < 4; ++i)
#pragma unroll
                for (int j = 0; j < 4; ++j) acc[i][j] += a[i] * b[j];
        }
        __syncthreads();
    }
#pragma unroll
    for (int i = 0; i < 4; ++i)
#pragma unroll
        for (int j = 0; j < 4; ++j) {
            int m = bm + ty * 4 + i, n = bn + tx * 4 + j;
            if (n < N) {
                if (EPI == 0) C[(size_t)m * ldc + n] = acc[i][j];
                else {
                    float gt = MODl[(size_t)(m < CTX ? 1 : 0) * 6 * D + gate_off + n];
                    C[(size_t)m * ldc + n] += gt * acc[i][j];
                }
            }
        }
}

__global__ void k_s5_scan(const float* __restrict__ P, const float* __restrict__ a_re, const float* __restrict__ a_im,
                          const float* __restrict__ log_step, const float* __restrict__ b_re, const float* __restrict__ b_im,
                          const float* __restrict__ c_re, const float* __restrict__ c_im, float* __restrict__ Y  ) {
    __shared__ float sh_hr[PS], sh_hi[PS];
    __shared__ float sh_cr[CG][PS], sh_ci[CG][PS];
    int g = blockIdx.x, dr = blockIdx.y, p = threadIdx.x;
    size_t gp = ((size_t)dr * G5 + g) * PS + p;
    float ar = a_re[gp], ai = a_im[gp];
    float dt = expf(log_step[(size_t)dr * G5 + g]);
    float er = expf(ar * dt);
    float lbr = er * cosf(ai * dt), lbi = er * sinf(ai * dt);
    float nr = lbr - 1.f, ni = lbi, den = ar * ar + ai * ai;
    float cfr = (nr * ar + ni * ai) / den, cfi = (ni * ar - nr * ai) / den;
    float bbr[CG], bbi[CG];
#pragma unroll
    for (int c = 0; c < CG; ++c) {
        float br = b_re[gp * CG + c], bi = b_im[gp * CG + c];
        bbr[c] = cfr * br - cfi * bi;
        bbi[c] = cfr * bi + cfi * br;
    }
    for (int c = 0; c < CG; ++c) {
        size_t ci = (((size_t)dr * G5 + g) * CG + c) * PS + p;
        sh_cr[c][p] = c_re[ci];
        sh_ci[c][p] = c_im[ci];
    }
    __syncthreads();
    float hr = 0.f, hi = 0.f;
    int c_out = p & 15, part = p >> 4;
    for (int j = 0; j < T; ++j) {
        int row = scan_row(dr, j);
        const float* u = P + (size_t)row * INW + O_S5 + g * CG;
        float bur = 0.f, bui = 0.f;
#pragma unroll
        for (int c = 0; c < CG; ++c) { float uv = u[c]; bur += uv * bbr[c]; bui += uv * bbi[c]; }
        float nhr = lbr * hr - lbi * hi + bur;
        float nhi = lbr * hi + lbi * hr + bui;
        hr = nhr; hi = nhi;
        __syncthreads();
        sh_hr[p] = hr; sh_hi[p] = hi;
        __syncthreads();
        float acc = 0.f;
#pragma unroll
        for (int q = 0; q < 16; ++q) {
            int pp = part * 16 + q;
            acc += sh_hr[pp] * sh_cr[c_out][pp] - sh_hi[pp] * sh_ci[c_out][pp];
        }
        acc += __shfl_xor(acc, 16);
        acc += __shfl_xor(acc, 32);
        if (part == 0) Y[((size_t)dr * T + row) * DS5 + g * CG + c_out] = acc;
    }
}

__global__ void k_s5_finish(const float* __restrict__ P, const float* __restrict__ Y, const float* __restrict__ d,
                            float* __restrict__ Z) {
    size_t i = (size_t)blockIdx.x * 256 + threadIdx.x;
    int row = i / DS5, ch = i % DS5;
    float u = P[(size_t)row * INW + O_S5 + ch];
    float y = Y[i] + Y[(size_t)T * DS5 + i] + d[ch] * u;
    Z[i] = gelu_f(y);
}
__global__ void k_s5_glu(const float* __restrict__ Z, const float* __restrict__ ZG, const float* __restrict__ b,
                         float* __restrict__ MIX) {
    size_t i = (size_t)blockIdx.x * 256 + threadIdx.x;
    int row = i / DS5, ch = i % DS5;
    MIX[(size_t)row * D + ch] = Z[i] * sigmoid_f(ZG[i] + b[ch]);
}

__global__ void k_gla_gate(const float* __restrict__ P, const float* __restrict__ w_alpha, const float* __restrict__ b_alpha,
                           float* __restrict__ G  ) {
    size_t i = (size_t)blockIdx.x * 256 + threadIdx.x;
    int j = i % DGK;
    int row = (i / DGK) % T;
    int dr = i / ((size_t)DGK * T);
    const float* lr = P + (size_t)row * INW + O_ALPHA + dr * RANK;
    float acc = b_alpha[dr * DGK + j];
#pragma unroll
    for (int r = 0; r < RANK; ++r) acc += lr[r] * w_alpha[((size_t)dr * RANK + r) * DGK + j];
    G[i] = logsigmoid_f(acc) * (1.f / 16.f);
}

__global__ void __launch_bounds__(256) k_gla_scan(const float* __restrict__ P, const float* __restrict__ G,
                                                   float* __restrict__ O  ) {
    __shared__ float s_q[DK], s_k[DK], s_e[DK];
    int head = blockIdx.x, dr = blockIdx.y, v = threadIdx.x;
    float S[DK];
#pragma unroll
    for (int k = 0; k < DK; ++k) S[k] = 0.f;
    const float qscale = 0.08838834764831845f;
    for (int j = 0; j < T; ++j) {
        int row = scan_row(dr, j);
        const float* pr = P + (size_t)row * INW;
        if (v < DK) {
            s_q[v] = pr[O_Q + head * DK + v] * qscale;
            s_k[v] = pr[O_K + head * DK + v];
            s_e[v] = expf(G[((size_t)dr * T + row) * DGK + head * DK + v]);
        }
        float vv = pr[O_V + head * DV + v];
        __syncthreads();
        float o = 0.f;
#pragma unroll
        for (int k = 0; k < DK; ++k) {
            S[k] = s_e[k] * S[k] + s_k[k] * vv;
            o += s_q[k] * S[k];
        }
        O[((size_t)dr * T + row) * DGV + head * DV + v] = o;
        __syncthreads();
    }
}

__global__ void k_gla_finish(const float* __restrict__ P, const float* __restrict__ O, const float* __restrict__ gn,
                             float* __restrict__ MIX) {
    __shared__ float red[4];
    int row = blockIdx.x, head = blockIdx.y, v = threadIdx.x;
    size_t i = (size_t)row * DGV + head * DV + v;
    float o = O[i] + O[(size_t)T * DGV + i];
    float ss = block_sum256(o * o, red);
    float rs = rsqrtf(ss / DV + EPS);
    float gate = P[(size_t)row * INW + O_GATE + head * DV + v];
    MIX[(size_t)row * D + DS5 + head * DV + v] = o * rs * gn[v] * silu_f(gate);
}

__global__ void k_hy_filter1(int n, const float* __restrict__ w1, const float* __restrict__ b1, const float* __restrict__ w2,
                             const float* __restrict__ b2, const float* __restrict__ freq, float* __restrict__ H2  ) {
    __shared__ float z[HYF], h1[HYH];
    int t = blockIdx.x, m = threadIdx.x;
    if (m < HYF) {
        float tn = (float)t / (float)(n - 1);
        float w = 2.0f * 3.14159265358979323846f * (float)t / (float)n;
        float val;
        if (m == 0) val = tn;
        else {
            int b = (m - 1) % 16;
            float band = 1e-4f + (float)b * ((15.0f - 1e-4f) / 15.0f);
            val = (m <= 16) ? cosf(band * w) : -sinf(band * w);
        }
        z[m] = val;
    }
    __syncthreads();
    float acc = b1[m];
    for (int f = 0; f < HYF; ++f) acc += z[f] * w1[f * HYH + m];
    h1[m] = sinf(freq[m] * acc);
    __syncthreads();
    float acc2 = b2[m];
    for (int k = 0; k < HYH; ++k) acc2 += h1[k] * w2[k * HYH + m];
    H2[(size_t)t * HYH + m] = sinf(freq[HYH + m] * acc2);
}
__global__ void k_hy_filter2(int n, const float* __restrict__ H2, const float* __restrict__ w3, const float* __restrict__ decay,
                             float* __restrict__ FILT) {
    size_t i = (size_t)blockIdx.x * 256 + threadIdx.x;
    int j = i % 1024, t = i / 1024;
    float acc = 0.f;
    for (int m = 0; m < HYH; ++m) acc += H2[(size_t)t * HYH + m] * w3[m * 1024 + j];
    float tn = (float)t / (float)(n - 1);
    FILT[i] = acc * expf(-tn * fabsf(decay[j]));
}
__global__ void k_hy_shortconv(const float* __restrict__ P, const float* __restrict__ cw, const float* __restrict__ cb,
                               float* __restrict__ ZC  ) {
    size_t i = (size_t)blockIdx.x * 256 + threadIdx.x;
    int c = i % 1536, row = i / 1536;
    int base = row < CTX ? 0 : CTX, n = row < CTX ? CTX : SEQ, li = row - base;
    float acc = cb[c];
#pragma unroll
    for (int j = 0; j < 3; ++j) {
        int s = li + j - 1;
        if (s >= 0 && s < n) acc += cw[j * 1536 + c] * P[(size_t)(base + s) * INW + O_HY + c];
    }
    ZC[i] = acc;
}
__global__ void k_hy_conv(const float* __restrict__ ZC, const float* __restrict__ FL, const float* __restrict__ FC,
                          const float* __restrict__ bias, float* __restrict__ MIX) {
    int c = blockIdx.x * 64 + (threadIdx.x & 63);
    int row = blockIdx.y * 4 + (threadIdx.x >> 6);
    int base = row < CTX ? 0 : CTX, n = row < CTX ? CTX : SEQ, li = row - base;
    const float* F = row < CTX ? FC : FL;
    float acc = 0.f;
    for (int s = 0; s < n; ++s) {
        const float* zr = ZC + (size_t)(base + s) * 1536;
        float sv = zr[512 + c] * zr[1024 + c];
        float f = (li >= s) ? F[(size_t)(li - s) * 1024 + c] : F[(size_t)(s - li) * 1024 + 512 + c];
        acc += f * sv;
    }
    const float* zr = ZC + (size_t)row * 1536;
    float si = zr[512 + c] * zr[1024 + c];
    MIX[(size_t)row * D + 1536 + c] = zr[c] * (acc + bias[c] * si);
}

__global__ void __launch_bounds__(64) k_peer_select(const float* __restrict__ Q, const float* __restrict__ keys  ,
                                                     int* __restrict__ IDX, float* __restrict__ GATE) {
    __shared__ float sc[64][257];
    int tok = blockIdx.x * 64 + threadIdx.x, h = blockIdx.y;
    const float* q = Q + (size_t)tok * D + h * PDQ;
    for (int s = 0; s < 2; ++s) {
        float qr[128];
#pragma unroll
        for (int d = 0; d < 128; ++d) qr[d] = q[s * 128 + d];
        const float* kb = keys + ((size_t)h * 2 + s) * PKEYS * 128;
        for (int k = 0; k < PKEYS; ++k) {
            float acc = 0.f;
#pragma unroll
            for (int d = 0; d < 128; ++d) acc += qr[d] * kb[k * 128 + d];
            sc[threadIdx.x][s * 128 + k] = acc;
        }
    }
    float tv[2][16]; int ti[2][16];
#pragma unroll
    for (int s = 0; s < 2; ++s)
#pragma unroll
        for (int j = 0; j < 16; ++j) { tv[s][j] = -INFINITY; ti[s][j] = 0; }
#pragma unroll
    for (int s = 0; s < 2; ++s) {
        for (int k = 0; k < PKEYS; ++k) {
            float c = sc[threadIdx.x][s * 128 + k]; int ci = k;
#pragma unroll
            for (int j = 0; j < 16; ++j) {
                bool gt = c > tv[s][j];
                float tvv = tv[s][j]; int tii = ti[s][j];
                tv[s][j] = gt ? c : tvv; ti[s][j] = gt ? ci : tii;
                c = gt ? tvv : c; ci = gt ? tii : ci;
            }
        }
    }
    float cv[16]; int cx[16];
#pragma unroll
    for (int j = 0; j < 16; ++j) { cv[j] = -INFINITY; cx[j] = 0; }
#pragma unroll
    for (int a = 0; a < 16; ++a)
#pragma unroll
        for (int b = 0; b < 16; ++b) {
            float c = tv[0][a] + tv[1][b]; int ci = ti[0][a] * PKEYS + ti[1][b];
#pragma unroll
            for (int j = 0; j < 16; ++j) {
                bool gt = c > cv[j];
                float tvv = cv[j]; int tii = cx[j];
                cv[j] = gt ? c : tvv; cx[j] = gt ? ci : tii;
                c = gt ? tvv : c; ci = gt ? tii : ci;
            }
        }
    float mx = cv[0], sum = 0.f, e[16];
#pragma unroll
    for (int j = 0; j < 16; ++j) { e[j] = expf(cv[j] - mx); sum += e[j]; }
    float inv = 1.f / sum;
#pragma unroll
    for (int j = 0; j < 16; ++j) {
        IDX[(size_t)tok * 128 + h * 16 + j] = cx[j];
        GATE[(size_t)tok * 128 + h * 16 + j] = e[j] * inv;
    }
}

__global__ void __launch_bounds__(256) k_peer_expert(const float* __restrict__ X, const int* __restrict__ IDX,
                                                      const float* __restrict__ GATE, const float* __restrict__ U,
                                                      const float* __restrict__ V, const float* __restrict__ MODl,
                                                      float* __restrict__ H) {
    __shared__ float wgt[128];
    __shared__ int eidx[128];
    int tok = blockIdx.x, tid = threadIdx.x, lane = tid & 63, w = tid >> 6;
    if (tid < 128) eidx[tid] = IDX[(size_t)tok * 128 + tid];
    const float* x = X + (size_t)tok * D;
    float4 xr[8];
#pragma unroll
    for (int i = 0; i < 8; ++i) xr[i] = *reinterpret_cast<const float4*>(x + i * 256 + lane * 4);
    __syncthreads();
    for (int e = w * 32; e < w * 32 + 32; ++e) {
        const float* ur = U + (size_t)eidx[e] * D;
        float acc = 0.f;
#pragma unroll
        for (int i = 0; i < 8; ++i) {
            float4 uv = *reinterpret_cast<const float4*>(ur + i * 256 + lane * 4);
            acc += xr[i].x * uv.x + xr[i].y * uv.y + xr[i].z * uv.z + xr[i].w * uv.w;
        }
        acc = wave_sum(acc);
        if (lane == 0) wgt[e] = GATE[(size_t)tok * 128 + e] * gelu_f(acc);
    }
    __syncthreads();
    float4 o0 = {0, 0, 0, 0}, o1 = {0, 0, 0, 0};
    for (int e = 0; e < 128; ++e) {
        const float* vr = V + (size_t)eidx[e] * D;
        float wg = wgt[e];
        float4 a = *reinterpret_cast<const float4*>(vr + tid * 4);
        float4 b = *reinterpret_cast<const float4*>(vr + 1024 + tid * 4);
        o0.x += wg * a.x; o0.y += wg * a.y; o0.z += wg * a.z; o0.w += wg * a.w;
        o1.x += wg * b.x; o1.y += wg * b.y; o1.z += wg * b.z; o1.w += wg * b.w;
    }
    const float* gt = MODl + (size_t)(tok < CTX ? 1 : 0) * 6 * D + 5 * D;
    float* h = H + (size_t)tok * D;
    int d0 = tid * 4, d1 = 1024 + tid * 4;
    h[d0 + 0] += gt[d0 + 0] * o0.x; h[d0 + 1] += gt[d0 + 1] * o0.y; h[d0 + 2] += gt[d0 + 2] * o0.z; h[d0 + 3] += gt[d0 + 3] * o0.w;
    h[d1 + 0] += gt[d1 + 0] * o1.x; h[d1 + 1] += gt[d1 + 1] * o1.y; h[d1 + 2] += gt[d1 + 2] * o1.z; h[d1 + 3] += gt[d1 + 3] * o1.w;
}

__global__ void k_final(const float* __restrict__ H, const float* __restrict__ g, float* __restrict__ out) {
    __shared__ float red[4];
    int t = blockIdx.x;
    const float* h = H + (size_t)(CTX + t) * D;
    float ss = 0.f;
    for (int d = threadIdx.x; d < D; d += 256) { float v = h[d]; ss += v * v; }
    ss = block_sum256(ss, red);
    float rs = rsqrtf(ss / D + EPS);
    for (int d = threadIdx.x; d < D; d += 256) out[(size_t)t * D + d] = h[d] * rs * g[d];
}


typedef unsigned short bf16_t;
typedef __attribute__((ext_vector_type(8))) short bf16x8;
typedef __attribute__((ext_vector_type(4))) float f32x4;
#define NTHR 256

__device__ __forceinline__ bf16_t f2bf(float f) {
    unsigned u = __float_as_uint(f);
    u += 0x7fffu + ((u >> 16) & 1u);
    return (bf16_t)(u >> 16);
}
__device__ __forceinline__ float bf2f(bf16_t b) { return __uint_as_float(((unsigned)b) << 16); }
__device__ __forceinline__ unsigned pack2bf(float lo, float hi) { return (unsigned)f2bf(lo) | ((unsigned)f2bf(hi) << 16); }

__device__ __forceinline__ int win_src_col(int n_out) {
    if (n_out < 3584) return n_out;
    if (n_out < 5120) return n_out + 32;
    if (n_out < 5152) return n_out - 1536;
    return -1;
}
template <int PERM>
__device__ __forceinline__ void phase_wt_convert(const float* __restrict__ W, int K, int N, bf16_t* __restrict__ Wt, int Nout, char* smem,
                                 int vb, int nb) {
    float* tile = (float*)smem;
    int tilesN = Nout / 64, tilesK = K / 64;
    for (int t = vb; t < tilesN * tilesK; t += nb) {
        int tn = t / tilesK, tk = t % tilesK;
        __syncthreads();
        for (int e = threadIdx.x; e < 64 * 64; e += NTHR) {
            int kk = e / 64, nn = e % 64;
            int n_out = tn * 64 + nn;
            int src = PERM ? win_src_col(n_out) : (n_out < N ? n_out : -1);
            tile[kk * 65 + nn] = (src >= 0) ? W[(size_t)(tk * 64 + kk) * N + src] : 0.f;
        }
        __syncthreads();
        for (int e = threadIdx.x; e < 64 * 64; e += NTHR) {
            int nn = e / 64, kk = e % 64;
            Wt[(size_t)(tn * 64 + nn) * K + tk * 64 + kk] = f2bf(tile[kk * 65 + nn]);
        }
    }
}
__device__ __forceinline__ void phase_convert(const float* __restrict__ src, bf16_t* __restrict__ dst, size_t n, int vb, int nb) {
    size_t n4 = n / 4;
    for (size_t i = (size_t)vb * NTHR + threadIdx.x; i < n4; i += (size_t)nb * NTHR) {
        float4 v = reinterpret_cast<const float4*>(src)[i];
        uint2 o; o.x = pack2bf(v.x, v.y); o.y = pack2bf(v.z, v.w);
        reinterpret_cast<uint2*>(dst)[i] = o;
    }
}

constexpr int GBM = 128, GBN = 128, GBK = 64, GLD = 72;
constexpr int GEMM_LDS = 2 * 2 * GBM * GLD * 2;

template <class Epi>
__device__ __forceinline__ void gemm_phase(const bf16_t* __restrict__ A, int lda, const bf16_t* __restrict__ Bt, int ldb, int Mtiles,
                           int Ntiles, int K, char* smem, int vb, int nb, Epi epi) {
    bf16_t* lds = (bf16_t*)smem;
    const int tid = threadIdx.x, wave = tid >> 6, lane = tid & 63, lr = lane & 15, lq = lane >> 4;
    const int wm = wave >> 1, wn = wave & 1;
    const int ldrow = tid >> 3, ldk = (tid & 7) * 8;
    const int KT = K / GBK;
    for (int tile = vb; tile < Mtiles * Ntiles; tile += nb) {
        const int tn = tile / Mtiles, tm = tile % Mtiles;
        const bf16_t* Ag = A + (size_t)(tm * GBM + ldrow) * lda + ldk;
        const bf16_t* Bg = Bt + (size_t)(tn * GBN + ldrow) * ldb + ldk;
        f32x4 acc[4][4];
#pragma unroll
        for (int i = 0; i < 4; ++i)
#pragma unroll
            for (int j = 0; j < 4; ++j) acc[i][j] = (f32x4){0.f, 0.f, 0.f, 0.f};
        uint4 ra0, ra1, ra2, ra3, rb0, rb1, rb2, rb3;
#define G_LOAD(KOFF)                                                                       \
        ra0 = *reinterpret_cast<const uint4*>(Ag + (size_t)(0) * lda + (KOFF));            \
        ra1 = *reinterpret_cast<const uint4*>(Ag + (size_t)(32) * lda + (KOFF));           \
        ra2 = *reinterpret_cast<const uint4*>(Ag + (size_t)(64) * lda + (KOFF));           \
        ra3 = *reinterpret_cast<const uint4*>(Ag + (size_t)(96) * lda + (KOFF));           \
        rb0 = *reinterpret_cast<const uint4*>(Bg + (size_t)(0) * ldb + (KOFF));            \
        rb1 = *reinterpret_cast<const uint4*>(Bg + (size_t)(32) * ldb + (KOFF));           \
        rb2 = *reinterpret_cast<const uint4*>(Bg + (size_t)(64) * ldb + (KOFF));           \
        rb3 = *reinterpret_cast<const uint4*>(Bg + (size_t)(96) * ldb + (KOFF));
#define G_STORE(BUF)                                                                                   \
        *reinterpret_cast<uint4*>(lds + (((BUF) * 2 + 0) * GBM + ldrow + 0) * GLD + ldk) = ra0;        \
        *reinterpret_cast<uint4*>(lds + (((BUF) * 2 + 0) * GBM + ldrow + 32) * GLD + ldk) = ra1;       \
        *reinterpret_cast<uint4*>(lds + (((BUF) * 2 + 0) * GBM + ldrow + 64) * GLD + ldk) = ra2;       \
        *reinterpret_cast<uint4*>(lds + (((BUF) * 2 + 0) * GBM + ldrow + 96) * GLD + ldk) = ra3;       \
        *reinterpret_cast<uint4*>(lds + (((BUF) * 2 + 1) * GBM + ldrow + 0) * GLD + ldk) = rb0;        \
        *reinterpret_cast<uint4*>(lds + (((BUF) * 2 + 1) * GBM + ldrow + 32) * GLD + ldk) = rb1;       \
        *reinterpret_cast<uint4*>(lds + (((BUF) * 2 + 1) * GBM + ldrow + 64) * GLD + ldk) = rb2;       \
        *reinterpret_cast<uint4*>(lds + (((BUF) * 2 + 1) * GBM + ldrow + 96) * GLD + ldk) = rb3;
        G_LOAD(0)
        __syncthreads();
        G_STORE(0)
        __syncthreads();
        for (int kt = 0; kt < KT; ++kt) {
            const int cur = kt & 1;
            if (kt + 1 < KT) { G_LOAD((kt + 1) * GBK) }
            const bf16_t* As = lds + (cur * 2 + 0) * GBM * GLD;
            const bf16_t* Bs = lds + (cur * 2 + 1) * GBM * GLD;
#pragma unroll
            for (int ks = 0; ks < 2; ++ks) {
                bf16x8 af[4], bfr[4];
#pragma unroll
                for (int i = 0; i < 4; ++i) {
                    af[i] = *reinterpret_cast<const bf16x8*>(As + (wm * 64 + i * 16 + lr) * GLD + ks * 32 + lq * 8);
                    bfr[i] = *reinterpret_cast<const bf16x8*>(Bs + (wn * 64 + i * 16 + lr) * GLD + ks * 32 + lq * 8);
                }
#pragma unroll
                for (int i = 0; i < 4; ++i)
#pragma unroll
                    for (int j = 0; j < 4; ++j)
                        acc[i][j] = __builtin_amdgcn_mfma_f32_16x16x32_bf16(af[i], bfr[j], acc[i][j], 0, 0, 0);
            }
            if (kt + 1 < KT) { G_STORE(cur ^ 1) }
            __syncthreads();
        }
#undef G_LOAD
#undef G_STORE
#pragma unroll
        for (int i = 0; i < 4; ++i)
#pragma unroll
            for (int j = 0; j < 4; ++j)
                epi(tm * GBM + wm * 64 + i * 16 + lq * 4, tn * GBN + wn * 64 + j * 16 + lr, acc[i][j]);
    }
}

struct EpiF32 {
    float* C; int ldc; int N;
    __device__ __forceinline__ void operator()(int m, int n, const f32x4& a) const {
        if (n < N) {
#pragma unroll
            for (int r = 0; r < 4; ++r) C[(size_t)(m + r) * ldc + n] = a[r];
        }
    }
};
struct EpiResid {
    float* H; const float* MODl; int gate_off;
    __device__ __forceinline__ void operator()(int m, int n, const f32x4& a) const {
        const float gt = MODl[(size_t)(m < CTX ? 1 : 0) * 6 * D + gate_off + n];
#pragma unroll
        for (int r = 0; r < 4; ++r) H[(size_t)(m + r) * D + n] += gt * a[r];
    }
};

__device__ __forceinline__ void phase_modulate_bf16(const float* __restrict__ H, const float* __restrict__ g, const float* __restrict__ MODl,
                                    int shift_off, int scale_off, bf16_t* __restrict__ OUT, int vb, int nb) {
    const int wave = threadIdx.x >> 6, lane = threadIdx.x & 63;
    for (int row = vb * 4 + wave; row < T; row += nb * 4) {
        const float* h = H + (size_t)row * D;
        float4 v[8];
        float ss = 0.f;
#pragma unroll
        for (int i = 0; i < 8; ++i) {
            v[i] = *reinterpret_cast<const float4*>(h + i * 256 + lane * 4);
            ss += v[i].x * v[i].x + v[i].y * v[i].y + v[i].z * v[i].z + v[i].w * v[i].w;
        }
        ss = wave_sum(ss);
        const float rs = rsqrtf(ss / D + EPS);
        const float* m = MODl + (size_t)(row < CTX ? 1 : 0) * 6 * D;
#pragma unroll
        for (int i = 0; i < 8; ++i) {
            const int d = i * 256 + lane * 4;
            const float4 gg = *reinterpret_cast<const float4*>(g + d);
            const float4 sc = *reinterpret_cast<const float4*>(m + scale_off + d);
            const float4 sh = *reinterpret_cast<const float4*>(m + shift_off + d);
            uint2 o;
            o.x = pack2bf(v[i].x * rs * gg.x * (1.f + sc.x) + sh.x, v[i].y * rs * gg.y * (1.f + sc.y) + sh.y);
            o.y = pack2bf(v[i].z * rs * gg.z * (1.f + sc.z) + sh.z, v[i].w * rs * gg.w * (1.f + sc.w) + sh.w);
            *reinterpret_cast<uint2*>(OUT + (size_t)row * D + d) = o;
        }
    }
}


__device__ __forceinline__ float bflo(unsigned w) { return __uint_as_float(w << 16); }
__device__ __forceinline__ float bfhi(unsigned w) { return __uint_as_float(w & 0xffff0000u); }
__device__ __forceinline__ float dot8(const uint4& u, const float* xf) {
    return bflo(u.x) * xf[0] + bfhi(u.x) * xf[1] + bflo(u.y) * xf[2] + bfhi(u.y) * xf[3] + bflo(u.z) * xf[4] + bfhi(u.z) * xf[5] +
           bflo(u.w) * xf[6] + bfhi(u.w) * xf[7];
}
__device__ __forceinline__ void axpy8(const uint4& v, float w, float* o) {
    o[0] += w * bflo(v.x); o[1] += w * bfhi(v.x); o[2] += w * bflo(v.y); o[3] += w * bfhi(v.y);
    o[4] += w * bflo(v.z); o[5] += w * bfhi(v.z); o[6] += w * bflo(v.w); o[7] += w * bfhi(v.w);
}
__device__ __forceinline__ void phase_peer_gather(const bf16_t* __restrict__ X, const int* __restrict__ IDX, const float* __restrict__ GATE,
                                  const bf16_t* __restrict__ Ub, const bf16_t* __restrict__ Vb, const float* __restrict__ MODl,
                                  float* __restrict__ H, int vb, int nb) {
    const int wave = threadIdx.x >> 6, lane = threadIdx.x & 63;
    for (int tok = vb * 4 + wave; tok < T; tok += nb * 4) {
        float xf[32], out[32];
#pragma unroll
        for (int i = 0; i < 4; ++i) {
            const uint4 xr = *reinterpret_cast<const uint4*>(X + (size_t)tok * D + i * 512 + lane * 8);
            xf[i * 8 + 0] = bflo(xr.x); xf[i * 8 + 1] = bfhi(xr.x); xf[i * 8 + 2] = bflo(xr.y); xf[i * 8 + 3] = bfhi(xr.y);
            xf[i * 8 + 4] = bflo(xr.z); xf[i * 8 + 5] = bfhi(xr.z); xf[i * 8 + 6] = bflo(xr.w); xf[i * 8 + 7] = bfhi(xr.w);
        }
#pragma unroll
        for (int i = 0; i < 32; ++i) out[i] = 0.f;
        const int id0 = IDX[(size_t)tok * 128 + lane], id1 = IDX[(size_t)tok * 128 + 64 + lane];
        const float g0 = GATE[(size_t)tok * 128 + lane], g1 = GATE[(size_t)tok * 128 + 64 + lane];
        for (int e0 = 0; e0 < 128; e0 += 4) {
            uint4 ur[4][4], vr[4][4];
            float gt[4];
#pragma unroll
            for (int k = 0; k < 4; ++k) {
                const int e = e0 + k;
                const int idx = __shfl(e < 64 ? id0 : id1, e & 63);
                gt[k] = __shfl(e < 64 ? g0 : g1, e & 63);
                const bf16_t* up = Ub + (size_t)idx * D + lane * 8;
                const bf16_t* vp = Vb + (size_t)idx * D + lane * 8;
#pragma unroll
                for (int i = 0; i < 4; ++i) {
                    ur[k][i] = *reinterpret_cast<const uint4*>(up + i * 512);
                    vr[k][i] = *reinterpret_cast<const uint4*>(vp + i * 512);
                }
            }
#pragma unroll
            for (int k = 0; k < 4; ++k) {
                float a = 0.f;
#pragma unroll
                for (int i = 0; i < 4; ++i) a += dot8(ur[k][i], xf + i * 8);
                a = wave_sum(a);
                const float w = gt[k] * gelu_f(a);
#pragma unroll
                for (int i = 0; i < 4; ++i) axpy8(vr[k][i], w, out + i * 8);
            }
        }
        const float* gt2 = MODl + (size_t)(tok < CTX ? 1 : 0) * 6 * D + 5 * D;
        float* h = H + (size_t)tok * D;
#pragma unroll
        for (int i = 0; i < 4; ++i) {
            const int d = i * 512 + lane * 8;
#pragma unroll
            for (int q = 0; q < 2; ++q) {
                float4 hv = *reinterpret_cast<float4*>(h + d + q * 4);
                const float4 gv = *reinterpret_cast<const float4*>(gt2 + d + q * 4);
                hv.x += gv.x * out[i * 8 + q * 4 + 0]; hv.y += gv.y * out[i * 8 + q * 4 + 1];
                hv.z += gv.z * out[i * 8 + q * 4 + 2]; hv.w += gv.w * out[i * 8 + q * 4 + 3];
                *reinterpret_cast<float4*>(h + d + q * 4) = hv;
            }
        }
    }
}


constexpr int PBW = 5120, PB_S5 = 0, PB_Q = 512, PB_K = 1024, PB_V = 1536, PB_GATE = 2560, PB_HY = 3584;
struct EpiInProj {
    bf16_t* PB; float* ALPHA; float* Pdev;
    __device__ __forceinline__ void operator()(int m, int n, const f32x4& a) const {
        if (n < PBW) {
#pragma unroll
            for (int r = 0; r < 4; ++r) PB[(size_t)(m + r) * PBW + n] = f2bf(a[r]);
        } else if (n < PBW + 32) {
#pragma unroll
            for (int r = 0; r < 4; ++r) ALPHA[(size_t)(m + r) * 32 + (n - PBW)] = a[r];
        }
        if (Pdev) {
            const int sc = win_src_col(n);
            if (sc >= 0) {
#pragma unroll
                for (int r = 0; r < 4; ++r) Pdev[(size_t)(m + r) * INW + sc] = a[r];
            }
        }
    }
};
struct EpiGLU {
    const bf16_t* Zb; const float* b; bf16_t* MIXb; float* MIXdev;
    __device__ __forceinline__ void operator()(int m, int n, const f32x4& a) const {
        const float bb = b[n];
#pragma unroll
        for (int r = 0; r < 4; ++r) {
            const float z = bf2f(Zb[(size_t)(m + r) * DS5 + n]);
            const float o = z * sigmoid_f(a[r] + bb);
            MIXb[(size_t)(m + r) * D + n] = f2bf(o);
            if (MIXdev) MIXdev[(size_t)(m + r) * D + n] = o;
        }
    }
};

constexpr int S5C = 64, S5NC = T / S5C;
__device__ __forceinline__ void phase_s5_tables(const float* a_re, const float* a_im, const float* log_step, const float* b_re,
                                                const float* b_im, const float* c_re, const float* c_im, float2* LAM,
                                                float2* BBAR, float2* CS, int vb, int nb) {
    for (int i = vb * NTHR + threadIdx.x; i < DEPTH * 2 * G5 * PS; i += nb * NTHR) {
        const int p = i % PS, ldg = i / PS;
        const float ar = a_re[i], ai = a_im[i];
        const float dt = expf(log_step[ldg]);
        const float er = expf(ar * dt);
        const float lbr = er * cosf(ai * dt), lbi = er * sinf(ai * dt);
        const float nr = lbr - 1.f, ni = lbi, den = ar * ar + ai * ai;
        const float cfr = (nr * ar + ni * ai) / den, cfi = (ni * ar - nr * ai) / den;
        LAM[i] = make_float2(lbr, lbi);
        for (int c = 0; c < CG; ++c) {
            const float br = b_re[(size_t)i * CG + c], bi = b_im[(size_t)i * CG + c];
            BBAR[(size_t)i * CG + c] = make_float2(cfr * br - cfi * bi, cfr * bi + cfi * br);
            const size_t ci = ((size_t)ldg * CG + c) * PS + p;
            CS[(size_t)i * CG + c] = make_float2(c_re[ci], c_im[ci]);
        }
    }
}
__device__ __forceinline__ int s5_chunk_index(int dir, int Rc) {
    if (dir == 0) return Rc;
    return (Rc < CTX / S5C) ? (CTX / S5C - 1 - Rc) : ((T + CTX) / S5C - 1 - Rc);
}
constexpr int S5_HROW = 130;
template <int MODE>
__device__ __forceinline__ void phase_s5_scan(int l, const bf16_t* PB, const float2* LAM, const float2* BBAR, const float2* CS,
                                              const float* dvec, float2* SE, const float2* HIN, bf16_t* Zb, float* Zdev,
                                              char* smem, int vb, int nb) {
    float* Us = (float*)smem;
    float* Hs = Us + 64 * 32;
    float* Cs = Hs + 4 * 8 * S5_HROW;
    float* Ys = Cs + 4 * 64 * 32;
    const int tid = threadIdx.x, wave = tid >> 6, lane = tid & 63;
    for (int unit = vb; unit < S5NC * 16; unit += nb) {
        const int Rc = unit >> 4, gp = unit & 15;
        const int g = gp * 2 + (wave >> 1), dir = wave & 1;
        const int r0 = Rc * S5C;
        const int ti = ((l * 2 + dir) * G5 + g) * PS + lane;
        __syncthreads();
        for (int e = tid; e < 64 * 16; e += NTHR) {
            const int t = e >> 4, c2 = (e & 15) * 2;
            const unsigned w = *reinterpret_cast<const unsigned*>(PB + (size_t)(r0 + t) * PBW + PB_S5 + gp * 32 + c2);
            Us[t * 32 + c2] = bflo(w);
            Us[t * 32 + c2 + 1] = bfhi(w);
        }
        if (MODE == 1) {
            const float4* src = reinterpret_cast<const float4*>(CS + (size_t)ti * CG);
            float4* dst = reinterpret_cast<float4*>(Cs + wave * 64 * 32 + lane * 32);
#pragma unroll
            for (int i = 0; i < 8; ++i) dst[i] = src[i];
        }
        const float2 lam = LAM[ti];
        float bbr[CG], bbi[CG];
#pragma unroll
        for (int c = 0; c < CG; ++c) { const float2 b = BBAR[(size_t)ti * CG + c]; bbr[c] = b.x; bbi[c] = b.y; }
        const int cidx = s5_chunk_index(dir, Rc);
        float hr = 0.f, hi = 0.f;
        if (MODE == 1) { const float2 h0 = HIN[((size_t)(dir * G5 + g) * S5NC + cidx) * PS + lane]; hr = h0.x; hi = h0.y; }
        __syncthreads();
        const float* ub = Us + (wave >> 1) * 16;
        float* hw = Hs + wave * 8 * S5_HROW;
        const float* cw = Cs + wave * 64 * 32;
        for (int tt = 0; tt < S5C; ++tt) {
            const int tl = dir == 0 ? tt : (S5C - 1 - tt);
            float bur = 0.f, bui = 0.f;
#pragma unroll
            for (int c4 = 0; c4 < 4; ++c4) {
                const float4 u = *reinterpret_cast<const float4*>(ub + tl * 32 + c4 * 4);
                bur += u.x * bbr[c4 * 4 + 0] + u.y * bbr[c4 * 4 + 1] + u.z * bbr[c4 * 4 + 2] + u.w * bbr[c4 * 4 + 3];
                bui += u.x * bbi[c4 * 4 + 0] + u.y * bbi[c4 * 4 + 1] + u.z * bbi[c4 * 4 + 2] + u.w * bbi[c4 * 4 + 3];
            }
            const float nhr = lam.x * hr - lam.y * hi + bur;
            const float nhi = lam.x * hi + lam.y * hr + bui;
            hr = nhr; hi = nhi;
            if (MODE == 1) {
                *reinterpret_cast<float2*>(hw + (tt & 7) * S5_HROW + lane * 2) = make_float2(hr, hi);
                if ((tt & 7) == 7) {
                    __builtin_amdgcn_wave_barrier();
                    const int ts = lane & 7, cq = lane >> 3;
                    float a0 = 0.f, a1 = 0.f;
#pragma unroll 8
                    for (int p = 0; p < PS; ++p) {
                        const float2 hv = *reinterpret_cast<const float2*>(hw + ts * S5_HROW + p * 2);
                        const float4 cc = *reinterpret_cast<const float4*>(cw + p * 32 + cq * 4);
                        a0 += hv.x * cc.x - hv.y * cc.y;
                        a1 += hv.x * cc.z - hv.y * cc.w;
                    }
                    const int tts = (tt - 7) + ts;
                    const int tls = dir == 0 ? tts : (S5C - 1 - tts);
                    *reinterpret_cast<float2*>(Ys + wave * 64 * 16 + tls * 16 + cq * 2) = make_float2(a0, a1);
                    __builtin_amdgcn_wave_barrier();
                }
            }
        }
        if (MODE == 0) {
            SE[((size_t)(dir * G5 + g) * S5NC + cidx) * PS + lane] = make_float2(hr, hi);
        } else {
            __syncthreads();
            for (int e = tid; e < 64 * 32; e += NTHR) {
                const int t = e >> 5, chl = e & 31, gs = chl >> 4, c = chl & 15;
                const int ch = gp * 32 + chl;
                const float y = Ys[(gs * 2 + 0) * 64 * 16 + t * 16 + c] + Ys[(gs * 2 + 1) * 64 * 16 + t * 16 + c] +
                                dvec[ch] * Us[t * 32 + chl];
                const float z = gelu_f(y);
                Zb[(size_t)(r0 + t) * DS5 + ch] = f2bf(z);
                if (Zdev) Zdev[(size_t)(r0 + t) * DS5 + ch] = z;
            }
        }
    }
}
constexpr int S5_LDS = (64 * 32 + 4 * 8 * S5_HROW + 4 * 64 * 32 + 4 * 64 * 16) * 4;

__device__ __forceinline__ void phase_s5_carry(int l, const float2* LAM, const float2* SE, float2* HIN, int vb, int nb) {
    for (int i = vb * NTHR + threadIdx.x; i < 2 * G5 * PS; i += nb * NTHR) {
        const int p = i % PS, dg = i / PS;
        float2 lm = LAM[(size_t)(l * 2 * G5 + dg) * PS + p];
#pragma unroll
        for (int s = 1; s < S5C; s <<= 1) lm = make_float2(lm.x * lm.x - lm.y * lm.y, 2.f * lm.x * lm.y);
        float hr = 0.f, hi = 0.f;
        const size_t base = (size_t)dg * S5NC * PS + p;
        for (int c0 = 0; c0 < S5NC; c0 += 12) {
            float2 e[12];
#pragma unroll
            for (int k = 0; k < 12; ++k) e[k] = SE[base + (size_t)(c0 + k) * PS];
#pragma unroll
            for (int k = 0; k < 12; ++k) {
                HIN[base + (size_t)(c0 + k) * PS] = make_float2(hr, hi);
                const float nr = lm.x * hr - lm.y * hi + e[k].x;
                const float ni = lm.x * hi + lm.y * hr + e[k].y;
                hr = nr; hi = ni;
            }
        }
    }
}
static_assert(S5NC % 12 == 0, "carry unroll");


constexpr int GSC = 256, GNS = T / GSC, GL_QD = 136, GL_KT = 72;
constexpr int GLA_LDS = 4096 + 1024 + 512 + 2 * 64 * GL_QD * 2 + 2 * 128 * GL_KT * 2;
constexpr int GLA_UNIT_F = 4 * 64 * 64;
template <int MODE>
__device__ __forceinline__ void phase_gla(const bf16_t* PB, const float* ALPHA, const float* w_alpha, const float* b_alpha,
                                          float* SLOC, float* DEC, const float* SIN, bf16_t* OG, char* smem, int vb, int nb) {
    float* As = (float*)smem;
    float* Bt = (float*)(smem + 4096);
    float* EB = (float*)(smem + 5120);
    bf16_t* Qd = (bf16_t*)(smem + 5632);
    bf16_t* Km = Qd + 64 * GL_QD;
    bf16_t* Att = Km;
    bf16_t* KeT = Km + 64 * GL_QD;
    bf16_t* VT = KeT + 128 * GL_KT;
    const int tid = threadIdx.x, wave = tid >> 6, lane = tid & 63, lr = lane & 15, lq = lane >> 4;
    const int k = tid & 127, half = tid >> 7;
    const float qscale = 0.08838834764831845f;
    for (int unit = vb; unit < GNS * 16; unit += nb) {
        const int vh = unit & 1, dir = (unit >> 1) & 1, head = (unit >> 2) & 3, sc = unit >> 4;
        f32x4 S[8][2];
#pragma unroll
        for (int m = 0; m < 8; ++m)
#pragma unroll
            for (int n = 0; n < 2; ++n) {
                if (MODE == 0) S[m][n] = (f32x4){0.f, 0.f, 0.f, 0.f};
                else {
#pragma unroll
                    for (int r = 0; r < 4; ++r)
                        S[m][n][r] = SIN[((size_t)(unit * 4 + wave) * 64 + (m * 2 + n) * 4 + r) * 64 + lane];
                }
            }
        float wcol[RANK];
#pragma unroll
        for (int r = 0; r < RANK; ++r) wcol[r] = w_alpha[(size_t)(dir * RANK + r) * DGK + head * DK + k];
        const float bcol = b_alpha[dir * DGK + head * DK + k];
        float dsum = 0.f;
        for (int ci = 0; ci < 4; ++ci) {
            const int j0 = sc * GSC + ci * 64;
            __syncthreads();
            for (int e = tid; e < 64 * 16; e += NTHR) {
                const int tt = e >> 4, r = e & 15;
                As[e] = ALPHA[(size_t)scan_row(dir, j0 + tt) * 32 + dir * 16 + r];
            }
            __syncthreads();
            float bl[32];
            {
                float b = 0.f;
#pragma unroll
                for (int i = 0; i < 32; ++i) {
                    const float* ar = As + (half * 32 + i) * 16;
                    float x = bcol;
#pragma unroll
                    for (int r = 0; r < RANK; ++r) x += ar[r] * wcol[r];
                    b += logsigmoid_f(x) * (1.f / 16.f);
                    bl[i] = b;
                }
                Bt[half * 128 + k] = b;
            }
            __syncthreads();
            const float b0 = Bt[k], blast = b0 + Bt[128 + k];
            if (half == 0) { EB[k] = expf(blast); dsum += blast; }
#pragma unroll
            for (int i = 0; i < 32; ++i) {
                const int tt = half * 32 + i;
                const float bb = bl[i] + (half ? b0 : 0.f);
                const bf16_t* pr = PB + (size_t)scan_row(dir, j0 + tt) * PBW;
                const float kv = bf2f(pr[PB_K + head * DK + k]);
                KeT[k * GL_KT + tt] = f2bf(kv * expf(blast - bb));
                if (MODE == 1) {
                    const float qv = bf2f(pr[PB_Q + head * DK + k]);
                    const float ee = expf(bb);
                    Qd[tt * GL_QD + k] = f2bf(qv * ee * qscale);
                    Km[tt * GL_QD + k] = f2bf(kv / ee);
                }
                VT[k * GL_KT + tt] = pr[PB_V + head * DV + vh * 128 + k];
            }
            __syncthreads();
            bf16x8 vtf[2][2];
#pragma unroll
            for (int ks = 0; ks < 2; ++ks)
#pragma unroll
                for (int n = 0; n < 2; ++n)
                    vtf[ks][n] = *reinterpret_cast<const bf16x8*>(VT + (32 * wave + 16 * n + lr) * GL_KT + ks * 32 + lq * 8);
            if (MODE == 1) {
                f32x4 at[4];
#pragma unroll
                for (int n = 0; n < 4; ++n) at[n] = (f32x4){0.f, 0.f, 0.f, 0.f};
#pragma unroll
                for (int ks = 0; ks < 4; ++ks) {
                    const bf16x8 a = *reinterpret_cast<const bf16x8*>(Qd + (16 * wave + lr) * GL_QD + ks * 32 + lq * 8);
#pragma unroll
                    for (int n = 0; n < 4; ++n) {
                        const bf16x8 bq = *reinterpret_cast<const bf16x8*>(Km + (16 * n + lr) * GL_QD + ks * 32 + lq * 8);
                        at[n] = __builtin_amdgcn_mfma_f32_16x16x32_bf16(a, bq, at[n], 0, 0, 0);
                    }
                }
                __syncthreads();
#pragma unroll
                for (int n = 0; n < 4; ++n)
#pragma unroll
                    for (int r = 0; r < 4; ++r) {
                        const int i = 16 * wave + 4 * lq + r, j = 16 * n + lr;
                        Att[i * GL_KT + j] = f2bf(j <= i ? at[n][r] : 0.f);
                    }
                __syncthreads();
                f32x4 o[4][2];
#pragma unroll
                for (int m = 0; m < 4; ++m)
#pragma unroll
                    for (int n = 0; n < 2; ++n) o[m][n] = (f32x4){0.f, 0.f, 0.f, 0.f};
#pragma unroll
                for (int m = 0; m < 4; ++m)
#pragma unroll
                    for (int ks = 0; ks < 2; ++ks) {
                        const bf16x8 a = *reinterpret_cast<const bf16x8*>(Att + (16 * m + lr) * GL_KT + ks * 32 + lq * 8);
#pragma unroll
                        for (int n = 0; n < 2; ++n) o[m][n] = __builtin_amdgcn_mfma_f32_16x16x32_bf16(a, vtf[ks][n], o[m][n], 0, 0, 0);
                    }
#pragma unroll
                for (int ks = 0; ks < 4; ++ks) {
                    bf16x8 sb[2];
#pragma unroll
                    for (int n = 0; n < 2; ++n) {
#pragma unroll
                        for (int r = 0; r < 4; ++r) {
                            sb[n][r] = (short)f2bf(S[2 * ks][n][r]);
                            sb[n][4 + r] = (short)f2bf(S[2 * ks + 1][n][r]);
                        }
                    }
#pragma unroll
                    for (int m = 0; m < 4; ++m) {
                        const bf16_t* qrow = Qd + (16 * m + lr) * GL_QD + ks * 32 + 4 * lq;
                        const uint2 lo = *reinterpret_cast<const uint2*>(qrow);
                        const uint2 hi = *reinterpret_cast<const uint2*>(qrow + 16);
                        union { uint4 u; bf16x8 v; } cv;
                        cv.u = make_uint4(lo.x, lo.y, hi.x, hi.y);
#pragma unroll
                        for (int n = 0; n < 2; ++n) o[m][n] = __builtin_amdgcn_mfma_f32_16x16x32_bf16(cv.v, sb[n], o[m][n], 0, 0, 0);
                    }
                }
#pragma unroll
                for (int m = 0; m < 4; ++m)
#pragma unroll
                    for (int r = 0; r < 4; ++r) {
                        const int row = scan_row(dir, j0 + 16 * m + 4 * lq + r);
                        bf16_t* og = OG + ((size_t)dir * T + row) * DGV + head * DV + vh * 128 + 32 * wave + lr;
#pragma unroll
                        for (int n = 0; n < 2; ++n) og[16 * n] = f2bf(o[m][n][r]);
                    }
            }
#pragma unroll
            for (int m = 0; m < 8; ++m) {
                const float4 eb = *reinterpret_cast<const float4*>(EB + 16 * m + 4 * lq);
#pragma unroll
                for (int n = 0; n < 2; ++n) { S[m][n][0] *= eb.x; S[m][n][1] *= eb.y; S[m][n][2] *= eb.z; S[m][n][3] *= eb.w; }
            }
#pragma unroll
            for (int ks = 0; ks < 2; ++ks)
#pragma unroll
                for (int m = 0; m < 8; ++m) {
                    const bf16x8 a = *reinterpret_cast<const bf16x8*>(KeT + (16 * m + lr) * GL_KT + ks * 32 + lq * 8);
#pragma unroll
                    for (int n = 0; n < 2; ++n) S[m][n] = __builtin_amdgcn_mfma_f32_16x16x32_bf16(a, vtf[ks][n], S[m][n], 0, 0, 0);
                }
        }
        if (MODE == 0) {
#pragma unroll
            for (int m = 0; m < 8; ++m)
#pragma unroll
                for (int n = 0; n < 2; ++n)
#pragma unroll
                    for (int r = 0; r < 4; ++r)
                        SLOC[((size_t)(unit * 4 + wave) * 64 + (m * 2 + n) * 4 + r) * 64 + lane] = S[m][n][r];
            if (vh == 0 && half == 0) DEC[(size_t)((sc * 4 + head) * 2 + dir) * 128 + k] = expf(dsum);
        }
    }
}
__device__ __forceinline__ void phase_gla_carry(const float* SLOC, const float* DEC, float* SIN, int vb, int nb) {
    for (int e = vb * NTHR + threadIdx.x; e < 16 * GLA_UNIT_F; e += nb * NTHR) {
        const int combo = e / GLA_UNIT_F, within = e % GLA_UNIT_F;
        const int head = combo >> 2, dir = (combo >> 1) & 1;
        const int reg = (within >> 6) & 63, lane = within & 63;
        const int kk = 16 * (reg >> 3) + 4 * (lane >> 4) + (reg & 3);
        float s = 0.f;
        for (int s0 = 0; s0 < GNS; s0 += 11) {
            float sl[11], dc[11];
#pragma unroll
            for (int i = 0; i < 11; ++i) {
                sl[i] = SLOC[(size_t)((s0 + i) * 16 + combo) * GLA_UNIT_F + within];
                dc[i] = DEC[(size_t)(((s0 + i) * 4 + head) * 2 + dir) * 128 + kk];
            }
#pragma unroll
            for (int i = 0; i < 11; ++i) {
                SIN[(size_t)((s0 + i) * 16 + combo) * GLA_UNIT_F + within] = s;
                s = dc[i] * s + sl[i];
            }
        }
    }
}
static_assert(GNS % 11 == 0, "gla carry unroll");
__device__ __forceinline__ void phase_gla_finish(const bf16_t* PB, const bf16_t* OG, const float* gn, bf16_t* MIXb, float* MIXdev,
                                                 int vb, int nb) {
    const int wave = threadIdx.x >> 6, lane = threadIdx.x & 63;
    for (int u = vb * 4 + wave; u < T * GH; u += nb * 4) {
        const int row = u >> 2, head = u & 3;
        const size_t oi = (size_t)row * DGV + head * DV + lane * 4;
        const uint2 a = *reinterpret_cast<const uint2*>(OG + oi);
        const uint2 b = *reinterpret_cast<const uint2*>(OG + (size_t)T * DGV + oi);
        float o[4] = {bflo(a.x) + bflo(b.x), bfhi(a.x) + bfhi(b.x), bflo(a.y) + bflo(b.y), bfhi(a.y) + bfhi(b.y)};
        float ss = o[0] * o[0] + o[1] * o[1] + o[2] * o[2] + o[3] * o[3];
        ss = wave_sum(ss);
        const float rs = rsqrtf(ss / DV + EPS);
        const uint2 gt = *reinterpret_cast<const uint2*>(PB + (size_t)row * PBW + PB_GATE + head * DV + lane * 4);
        const float gv[4] = {bflo(gt.x), bfhi(gt.x), bflo(gt.y), bfhi(gt.y)};
        float res[4];
#pragma unroll
        for (int i = 0; i < 4; ++i) res[i] = o[i] * rs * gn[lane * 4 + i] * silu_f(gv[i]);
        uint2 pk; pk.x = pack2bf(res[0], res[1]); pk.y = pack2bf(res[2], res[3]);
        *reinterpret_cast<uint2*>(MIXb + (size_t)row * D + DS5 + head * DV + lane * 4) = pk;
        if (MIXdev) {
#pragma unroll
            for (int i = 0; i < 4; ++i) MIXdev[(size_t)row * D + DS5 + head * DV + lane * 4 + i] = res[i];
        }
    }
}


constexpr int HYF_LDS = (64 * 36 + 64 * 64 + 64 * 64) * 4 + 256 * 72 * 2;
__device__ __forceinline__ void phase_hy_filter(const float* w1a, const float* b1a, const float* w2a, const float* b2a,
                                                const float* w3a, const float* fqa, const float* dca, bf16_t* FILT,
                                                bf16_t* FILTC, char* smem, int vb, int nb) {
    float* zs = (float*)smem;
    float* h1s = zs + 64 * 36;
    float* h2s = h1s + 64 * 64;
    bf16_t* outs = (bf16_t*)(h2s + 64 * 64);
    const int tid = threadIdx.x;
    for (int unit = vb; unit < DEPTH * 132; unit += nb) {
        const int l = unit / 132, ti = unit % 132;
        const int isctx = ti >= 128, n = isctx ? CTX : SEQ, t0 = (isctx ? ti - 128 : ti) * 64;
        const float* w1 = w1a + (size_t)l * HYF * HYH; const float* b1 = b1a + (size_t)l * HYH;
        const float* w2 = w2a + (size_t)l * HYH * HYH; const float* b2 = b2a + (size_t)l * HYH;
        const float* w3 = w3a + (size_t)l * HYH * 1024; const float* fq = fqa + (size_t)l * 2 * HYH;
        const float* dc = dca + (size_t)l * 2 * DHY;
        __syncthreads();
        for (int e = tid; e < 64 * HYF; e += NTHR) {
            const int t = e / HYF, f = e % HYF, tg = t0 + t;
            const float tn = (float)tg / (float)(n - 1);
            const float w = 2.0f * 3.14159265358979323846f * (float)tg / (float)n;
            float val;
            if (f == 0) val = tn;
            else {
                const int b = (f - 1) % 16;
                const float band = 1e-4f + (float)b * ((15.0f - 1e-4f) / 15.0f);
                val = (f <= 16) ? cosf(band * w) : -sinf(band * w);
            }
            zs[t * 36 + f] = val;
        }
        __syncthreads();
        {
            const int m = tid & 63, tq = tid >> 6;
            float wc[HYF];
#pragma unroll
            for (int f = 0; f < HYF; ++f) wc[f] = w1[f * HYH + m];
            const float bb = b1[m], ff = fq[m];
            for (int i = 0; i < 16; ++i) {
                const int t = tq * 16 + i;
                float acc = bb;
#pragma unroll
                for (int f = 0; f < HYF; ++f) acc += zs[t * 36 + f] * wc[f];
                h1s[t * 64 + m] = sinf(ff * acc);
            }
        }
        __syncthreads();
        {
            const int m = tid & 63, tq = tid >> 6;
            float wc[HYH];
#pragma unroll
            for (int k = 0; k < HYH; ++k) wc[k] = w2[k * HYH + m];
            const float bb = b2[m], ff = fq[HYH + m];
            for (int i = 0; i < 16; ++i) {
                const int t = tq * 16 + i;
                float acc = bb;
#pragma unroll
                for (int k = 0; k < HYH; ++k) acc += h1s[t * 64 + k] * wc[k];
                h2s[t * 64 + m] = sinf(ff * acc);
            }
        }
        __syncthreads();
        for (int jq = 0; jq < 4; ++jq) {
            const int j = jq * 256 + tid;
            float wc[HYH];
#pragma unroll
            for (int k = 0; k < HYH; ++k) wc[k] = w3[k * 1024 + j];
            const float dk = fabsf(dc[j]);
            for (int t = 0; t < 64; ++t) {
                float acc = 0.f;
#pragma unroll
                for (int k = 0; k < HYH; ++k) acc += h2s[t * 64 + k] * wc[k];
                const float tn = (float)(t0 + t) / (float)(n - 1);
                outs[tid * 72 + t] = f2bf(acc * expf(-tn * dk));
            }
            __syncthreads();
            for (int e = tid; e < 256 * 64; e += NTHR) {
                const int jl = e >> 6, t = e & 63;
                const int jj = jq * 256 + jl, dirn = jj >> 9, c = jj & 511;
                const int lag = t0 + t;
                if (dirn == 1 && lag == 0) continue;
                const bf16_t v = outs[jl * 72 + t];
                if (isctx) FILTC[((size_t)l * DHY + c) * 512 + (dirn ? 256 - lag : 256 + lag)] = v;
                else FILT[((size_t)l * DHY + c) * 16384 + (dirn ? 8192 - lag : 8192 + lag)] = v;
            }
            __syncthreads();
        }
    }
}
constexpr int HYS_LDS = 64 * 72 * 2;
__device__ __forceinline__ void phase_hy_short(const bf16_t* PB, const float* cw, const float* cb, bf16_t* X0b, bf16_t* ST,
                                               char* smem, int vb, int nb) {
    bf16_t* ts = (bf16_t*)smem;
    const int tid = threadIdx.x;
    for (int unit = vb; unit < (T / 64) * 8; unit += nb) {
        const int rt = unit >> 3, cg = unit & 7, r0 = rt * 64;
        const int base = r0 < CTX ? 0 : CTX, n = r0 < CTX ? CTX : SEQ;
        __syncthreads();
        for (int e = tid; e < 64 * 64; e += NTHR) {
            const int pos = e >> 6, ch = e & 63, c = cg * 64 + ch, row = r0 + pos, li = row - base;
            float z[3];
#pragma unroll
            for (int part = 0; part < 3; ++part) {
                const int cc = part * 512 + c;
                float acc = cb[cc];
#pragma unroll
                for (int j = 0; j < 3; ++j) {
                    const int s = li + j - 1;
                    if (s >= 0 && s < n) acc += cw[j * 1536 + cc] * bf2f(PB[(size_t)(base + s) * PBW + PB_HY + cc]);
                }
                z[part] = acc;
            }
            X0b[(size_t)row * DHY + c] = f2bf(z[0]);
            ts[ch * 72 + pos] = f2bf(z[1] * z[2]);
        }
        __syncthreads();
        for (int e = tid; e < 64 * 8; e += NTHR) {
            const int ch = e >> 3, p8 = (e & 7) * 8;
            *reinterpret_cast<uint4*>(ST + (size_t)(cg * 64 + ch) * T + r0 + p8) = *reinterpret_cast<const uint4*>(ts + ch * 72 + p8);
        }
    }
}
constexpr int HYC_LDS = 32768 + 16384 + 16384;
__device__ __forceinline__ void phase_hy_conv(int l, const bf16_t* FILT, const bf16_t* FILTC, const bf16_t* ST, bf16_t* YT,
                                              char* smem, int vb, int nb) {
    bf16_t* fl = (bf16_t*)smem;
    bf16_t* xs = (bf16_t*)(smem + 32768);
    bf16_t* ys = (bf16_t*)(smem + 49152);
    const int tid = threadIdx.x, wave = tid >> 6, lane = tid & 63, lr = lane & 15, lq = lane >> 4;
    for (int unit = vb; unit < 2 * DHY; unit += nb) {
        const int seq = unit >> 9, c = unit & 511;
        const int n = seq ? CTX : SEQ, NB = n / 64, off = seq ? 0 : CTX, FC = seq ? 256 : 8192;
        const bf16_t* F = seq ? FILTC + ((size_t)l * DHY + c) * 512 : FILT + ((size_t)l * DHY + c) * 16384;
        __syncthreads();
        for (int e = tid; e < 2 * n / 8; e += NTHR) reinterpret_cast<uint4*>(fl)[e] = reinterpret_cast<const uint4*>(F)[e];
        for (int e = tid; e < n / 8; e += NTHR)
            reinterpret_cast<uint4*>(xs)[e] = *reinterpret_cast<const uint4*>(ST + (size_t)c * T + off + e * 8);
        __syncthreads();
        f32x4 acc[8];
#pragma unroll
        for (int i = 0; i < 8; ++i) acc[i] = (f32x4){0.f, 0.f, 0.f, 0.f};
        for (int dl = -(NB - 1); dl <= NB - 1; ++dl) {
            const int Ilo = dl > 0 ? dl : 0, Ihi = dl < 0 ? NB - 1 + dl : NB - 1;
            const int ntlo = Ilo >> 4, nthi = Ihi >> 4;
            bf16x8 a[2];
#pragma unroll
            for (int ks = 0; ks < 2; ++ks) {
                const int x = FC + 64 * dl + 16 * wave + lr - 32 * ks - 8 * lq;
#pragma unroll
                for (int e = 0; e < 8; ++e) a[ks][e] = (short)fl[x - e];
            }
#pragma unroll
            for (int nt = 0; nt < 8; ++nt) {
                if (nt >= ntlo && nt <= nthi) {
                    const int J = 16 * nt + lr - dl;
                    const bool valid = (J >= 0) && (J < NB);
                    const int Jc = valid ? J : 0;
#pragma unroll
                    for (int ks = 0; ks < 2; ++ks) {
                        uint4 bv = *reinterpret_cast<const uint4*>(xs + 64 * Jc + 32 * ks + 8 * lq);
                        if (!valid) bv = make_uint4(0u, 0u, 0u, 0u);
                        union { uint4 u; bf16x8 v; } cv;
                        cv.u = bv;
                        acc[nt] = __builtin_amdgcn_mfma_f32_16x16x32_bf16(a[ks], cv.v, acc[nt], 0, 0, 0);
                    }
                }
            }
        }
#pragma unroll
        for (int nt = 0; nt < 8; ++nt) {
            const int I = 16 * nt + lr;
            if (I < NB) {
                uint2 pk;
                pk.x = pack2bf(acc[nt][0], acc[nt][1]);
                pk.y = pack2bf(acc[nt][2], acc[nt][3]);
                *reinterpret_cast<uint2*>(ys + 64 * I + 16 * wave + 4 * lq) = pk;
            }
        }
        __syncthreads();
        for (int e = tid; e < n / 8; e += NTHR)
            *reinterpret_cast<uint4*>(YT + (size_t)c * T + off + e * 8) = reinterpret_cast<const uint4*>(ys)[e];
    }
}
constexpr int HYN_LDS = 2 * 64 * 72 * 2;
__device__ __forceinline__ void phase_hy_finish(const bf16_t* X0b, const bf16_t* ST, const bf16_t* YT, const float* bias,
                                                bf16_t* MIXb, float* MIXdev, char* smem, int vb, int nb) {
    bf16_t* ss = (bf16_t*)smem;
    bf16_t* yy = ss + 64 * 72;
    const int tid = threadIdx.x;
    for (int unit = vb; unit < (T / 64) * 8; unit += nb) {
        const int rt = unit >> 3, cg = unit & 7, r0 = rt * 64;
        __syncthreads();
        for (int e = tid; e < 64 * 8; e += NTHR) {
            const int ch = e >> 3, p8 = (e & 7) * 8;
            *reinterpret_cast<uint4*>(ss + ch * 72 + p8) = *reinterpret_cast<const uint4*>(ST + (size_t)(cg * 64 + ch) * T + r0 + p8);
            *reinterpret_cast<uint4*>(yy + ch * 72 + p8) = *reinterpret_cast<const uint4*>(YT + (size_t)(cg * 64 + ch) * T + r0 + p8);
        }
        __syncthreads();
        for (int e = tid; e < 64 * 64; e += NTHR) {
            const int pos = e >> 6, ch = e & 63, c = cg * 64 + ch, row = r0 + pos;
            const float x0 = bf2f(X0b[(size_t)row * DHY + c]);
            const float o = x0 * (bf2f(yy[ch * 72 + pos]) + bias[c] * bf2f(ss[ch * 72 + pos]));
            MIXb[(size_t)row * D + 1536 + c] = f2bf(o);
            if (MIXdev) MIXdev[(size_t)row * D + 1536 + c] = o;
        }
    }
}

#define XB_TMO      128
#define XB_XCNT(j)  (256  + 64 * (j))
#define XB_XSUB(j)  (1280 + 64 * (j))
#define XB_XGEN(j)  (2304 + 64 * (j))
#define XB_TOP      3328
#define XB_TOPGEN   3392
#define XCD_BAR_WORDS 3456
#define XB_SPIN_CAP (1u << 18)
#define LAS __attribute__((address_space(3)))

__device__ __forceinline__ unsigned xb_ld(unsigned* p)              { return __hip_atomic_load(p, __ATOMIC_RELAXED, __HIP_MEMORY_SCOPE_AGENT); }
__device__ __forceinline__ unsigned xb_add(unsigned* p, unsigned v) { return __hip_atomic_fetch_add(p, v, __ATOMIC_RELAXED, __HIP_MEMORY_SCOPE_AGENT); }
__device__ __forceinline__ unsigned xb_xcc_id() { return (unsigned)__builtin_amdgcn_s_getreg((3 << 11) | 20) & 0xFu; }
#define XB_SPIN(cond, bar) do { unsigned _sp = 0; while (cond) { __builtin_amdgcn_s_sleep(1); \
    if ((++_sp & 255u) == 0u) { if (xb_ld(&(bar)[XB_TMO])) break; if (_sp > XB_SPIN_CAP) { atomicAdd(&(bar)[XB_TMO], 1u); break; } } } } while (0)

struct XcdBarrier {
    unsigned* bar; unsigned x;
    volatile LAS unsigned* st;
};

__device__ __forceinline__ XcdBarrier xcd_barrier_post(unsigned* bar, volatile LAS unsigned* st) {
    XcdBarrier b; b.bar = bar; b.x = xb_xcc_id(); b.st = st;
    if (threadIdx.x == 0) (void)xb_add(&bar[XB_XCNT(b.x)], 1u);
    return b;
}
__device__ __forceinline__ void xcd_barrier_complete(unsigned* bar, unsigned x, unsigned& nloc, unsigned& nx) {
    const unsigned G = gridDim.x * gridDim.y * gridDim.z;
    unsigned sum, cnt, mine, sp = 0u;
    for (;;) {
        sum = 0u; cnt = 0u; mine = 0u;
#pragma unroll
        for (unsigned j = 0; j < 16; ++j) { const unsigned c = xb_ld(&bar[XB_XCNT(j)]); sum += c; cnt += (c > 0u) ? 1u : 0u; mine = (j == x) ? c : mine; }
        if (sum == G) break;
        __builtin_amdgcn_s_sleep(1);
        if ((++sp & 255u) == 0u) { if (xb_ld(&bar[XB_TMO])) break; if (sp > XB_SPIN_CAP) { atomicAdd(&bar[XB_TMO], 1u); break; } }
    }
    nloc = mine > 0u ? mine : 1u; nx = cnt > 0u ? cnt : 1u;
}

__device__ __forceinline__ void xcd_barrier(const XcdBarrier& b) {
    asm volatile("s_waitcnt vmcnt(0)" ::: "memory");
    __syncthreads();
    if (threadIdx.x == 0) {
        unsigned* bar = b.bar;
        __builtin_amdgcn_s_waitcnt(0);
        unsigned nloc = b.st[0], nx = b.st[1];
        if (nloc == 0u) { xcd_barrier_complete(bar, b.x, nloc, nx); b.st[0] = nloc; b.st[1] = nx; }
        const unsigned old = xb_add(&bar[XB_XSUB(b.x)], 1u);
        const unsigned gen = old / nloc;
        if (old + 1u == (gen + 1u) * nloc) {
            __builtin_amdgcn_fence(__ATOMIC_RELEASE, "agent");
            asm volatile("s_waitcnt vmcnt(0)" ::: "memory");
            const unsigned og = xb_add(&bar[XB_TOP], 1u);
            const unsigned tg = og / nx;
            if (og + 1u == (tg + 1u) * nx) xb_add(&bar[XB_TOPGEN], 1u);
            else XB_SPIN(xb_ld(&bar[XB_TOPGEN]) == tg, bar);
            __builtin_amdgcn_fence(__ATOMIC_ACQUIRE, "agent");
            xb_add(&bar[XB_XGEN(b.x)], 1u);
            asm volatile("s_waitcnt vmcnt(0)" ::: "memory");
        } else {
            XB_SPIN(xb_ld(&bar[XB_XGEN(b.x)]) == gen, bar);
            __builtin_amdgcn_fence(__ATOMIC_ACQUIRE, "agent");
            asm volatile("s_waitcnt vmcnt(0)" ::: "memory");
        }
    }
    __syncthreads();
}


__device__ __forceinline__ void grid_sync(const XcdBarrier& b) {
    xcd_barrier(b);
}
constexpr int MEGA_LDS = GEMM_LDS + 16;

extern __shared__ __attribute__((aligned(16))) char dyn_smem[];
template <int PERM>
__global__ void __launch_bounds__(NTHR, 2) kw_wt_convert(const float* W, int K, int N, bf16_t* Wt, int Nout) {
    phase_wt_convert<PERM>(W, K, N, Wt, Nout, dyn_smem, blockIdx.x, gridDim.x);
}
__global__ void __launch_bounds__(NTHR, 2) kw_convert(const float* src, bf16_t* dst, size_t n) {
    phase_convert(src, dst, n, blockIdx.x, gridDim.x);
}
__global__ void __launch_bounds__(NTHR, 2) kw_gemm_f32(const bf16_t* A, int lda, const bf16_t* Bt, int ldb, int Mt, int Nt, int K,
                                                       float* C, int ldc, int N) {
    gemm_phase(A, lda, Bt, ldb, Mt, Nt, K, dyn_smem, blockIdx.x, gridDim.x, EpiF32{C, ldc, N});
}
__global__ void __launch_bounds__(NTHR, 2) kw_gemm_resid(const bf16_t* A, int lda, const bf16_t* Bt, int ldb, int Mt, int Nt, int K,
                                                         float* H, const float* MODl, int gate_off) {
    gemm_phase(A, lda, Bt, ldb, Mt, Nt, K, dyn_smem, blockIdx.x, gridDim.x, EpiResid{H, MODl, gate_off});
}
__global__ void __launch_bounds__(NTHR, 2) k_mega_test(unsigned* bar, const float* H, const float* g, const float* MODl, bf16_t* A1b,
                                                       const bf16_t* WinT, float* P) {
    if (threadIdx.x == 0) *reinterpret_cast<uint4*>(dyn_smem + GEMM_LDS) = make_uint4(0u, 0u, 0u, 0u);
    __syncthreads();
    XcdBarrier xb = xcd_barrier_post(bar, (volatile LAS unsigned*)(dyn_smem + GEMM_LDS));
    phase_modulate_bf16(H, g, MODl, 0, D, A1b, blockIdx.x, gridDim.x);
    grid_sync(xb);
    gemm_phase(A1b, D, WinT, D, T / GBM, 5248 / GBN, D, dyn_smem, blockIdx.x, gridDim.x, EpiF32{P, INW, INW});
    grid_sync(xb);
}
__global__ void __launch_bounds__(NTHR, 2) kw_gemm_inproj(const bf16_t* A, const bf16_t* Bt, bf16_t* PB, float* ALPHA, float* Pdev) {
    gemm_phase(A, D, Bt, D, T / GBM, 5248 / GBN, D, dyn_smem, blockIdx.x, gridDim.x, EpiInProj{PB, ALPHA, Pdev});
}
__global__ void __launch_bounds__(NTHR, 2) kw_gemm_glu(const bf16_t* Zb, const bf16_t* Wt, const float* b, bf16_t* MIXb, float* MIXdev) {
    gemm_phase(Zb, DS5, Wt, DS5, T / GBM, DS5 / GBN, DS5, dyn_smem, blockIdx.x, gridDim.x, EpiGLU{Zb, b, MIXb, MIXdev});
}
__global__ void __launch_bounds__(NTHR, 2) kw_s5_tables(const float* a_re, const float* a_im, const float* log_step, const float* b_re,
                                                        const float* b_im, const float* c_re, const float* c_im, float2* LAM,
                                                        float2* BBAR, float2* CS) {
    phase_s5_tables(a_re, a_im, log_step, b_re, b_im, c_re, c_im, LAM, BBAR, CS, blockIdx.x, gridDim.x);
}
template <int MODE>
__global__ void __launch_bounds__(NTHR, 2) kw_s5_scan(int l, const bf16_t* PB, const float2* LAM, const float2* BBAR, const float2* CS,
                                                      const float* dvec, float2* SE, const float2* HIN, bf16_t* Zb, float* Zdev) {
    phase_s5_scan<MODE>(l, PB, LAM, BBAR, CS, dvec, SE, HIN, Zb, Zdev, dyn_smem, blockIdx.x, gridDim.x);
}
__global__ void __launch_bounds__(NTHR, 2) kw_s5_carry(int l, const float2* LAM, const float2* SE, float2* HIN) {
    phase_s5_carry(l, LAM, SE, HIN, blockIdx.x, gridDim.x);
}
template <int MODE>
__global__ void __launch_bounds__(NTHR, 2) kw_gla(const bf16_t* PB, const float* ALPHA, const float* w_alpha, const float* b_alpha,
                                                  float* SLOC, float* DEC, const float* SIN, bf16_t* OG) {
    phase_gla<MODE>(PB, ALPHA, w_alpha, b_alpha, SLOC, DEC, SIN, OG, dyn_smem, blockIdx.x, gridDim.x);
}
__global__ void __launch_bounds__(NTHR, 2) kw_gla_carry(const float* SLOC, const float* DEC, float* SIN) {
    phase_gla_carry(SLOC, DEC, SIN, blockIdx.x, gridDim.x);
}
__global__ void __launch_bounds__(NTHR, 2) kw_gla_finish(const bf16_t* PB, const bf16_t* OG, const float* gn, bf16_t* MIXb, float* MIXdev) {
    phase_gla_finish(PB, OG, gn, MIXb, MIXdev, blockIdx.x, gridDim.x);
}
__global__ void __launch_bounds__(NTHR, 2) kw_hy_filter(const float* w1, const float* b1, const float* w2, const float* b2, const float* w3,
                                                        const float* fq, const float* dc, bf16_t* FILT, bf16_t* FILTC) {
    phase_hy_filter(w1, b1, w2, b2, w3, fq, dc, FILT, FILTC, dyn_smem, blockIdx.x, gridDim.x);
}
__global__ void __launch_bounds__(NTHR, 2) kw_hy_short(const bf16_t* PB, const float* cw, const float* cb, bf16_t* X0b, bf16_t* ST) {
    phase_hy_short(PB, cw, cb, X0b, ST, dyn_smem, blockIdx.x, gridDim.x);
}
__global__ void __launch_bounds__(NTHR, 2) kw_hy_conv(int l, const bf16_t* FILT, const bf16_t* FILTC, const bf16_t* ST, bf16_t* YT) {
    phase_hy_conv(l, FILT, FILTC, ST, YT, dyn_smem, blockIdx.x, gridDim.x);
}
__global__ void __launch_bounds__(NTHR, 2) kw_hy_finish(const bf16_t* X0b, const bf16_t* ST, const bf16_t* YT, const float* bias,
                                                        bf16_t* MIXb, float* MIXdev) {
    phase_hy_finish(X0b, ST, YT, bias, MIXb, MIXdev, dyn_smem, blockIdx.x, gridDim.x);
}
__global__ void __launch_bounds__(NTHR, 2) kw_peer_gather(const bf16_t* X, const int* IDX, const float* GATE, const bf16_t* Ub,
                                                          const bf16_t* Vb, const float* MODl, float* H) {
    phase_peer_gather(X, IDX, GATE, Ub, Vb, MODl, H, blockIdx.x, gridDim.x);
}
__global__ void __launch_bounds__(NTHR, 2) kw_modulate_bf16(const float* H, const float* g, const float* MODl, int shift_off,
                                                            int scale_off, bf16_t* OUT) {
    phase_modulate_bf16(H, g, MODl, shift_off, scale_off, OUT, blockIdx.x, gridDim.x);
}

extern "C" void kernel_launch(void* const* d_in, const int* in_sizes, int n_in, void* d_out, int out_size, void* d_ws,
                              size_t ws_size, hipStream_t stream) {
    const float* x = (const float*)d_in[0];
    const float* c = (const float*)d_in[1];
    const float* ctx = (const float*)d_in[2];
    const float* c_ctx = (const float*)d_in[3];
    const float* w_ada = (const float*)d_in[4];
    const float* b_ada = (const float*)d_in[5];
    const float* g_norm1 = (const float*)d_in[6];
    const float* g_norm2 = (const float*)d_in[7];
    const float* w_in = (const float*)d_in[8];
    const float* s5_a_re = (const float*)d_in[9];
    const float* s5_a_im = (const float*)d_in[10];
    const float* s5_log_step = (const float*)d_in[11];
    const float* s5_b_re = (const float*)d_in[12];
    const float* s5_b_im = (const float*)d_in[13];
    const float* s5_c_re = (const float*)d_in[14];
    const float* s5_c_im = (const float*)d_in[15];
    const float* s5_d = (const float*)d_in[16];
    const float* s5_w_glu = (const float*)d_in[17];
    const float* s5_b_glu = (const float*)d_in[18];
    const float* gla_w_alpha = (const float*)d_in[19];
    const float* gla_b_alpha = (const float*)d_in[20];
    const float* gla_g_norm = (const float*)d_in[21];
    const float* hy_conv_w = (const float*)d_in[22];
    const float* hy_conv_b = (const float*)d_in[23];
    const float* hy_f_w1 = (const float*)d_in[24];
    const float* hy_f_b1 = (const float*)d_in[25];
    const float* hy_f_w2 = (const float*)d_in[26];
    const float* hy_f_b2 = (const float*)d_in[27];
    const float* hy_f_w3 = (const float*)d_in[28];
    const float* hy_f_freq = (const float*)d_in[29];
    const float* hy_decay = (const float*)d_in[30];
    const float* hy_bias = (const float*)d_in[31];
    const float* w_out = (const float*)d_in[32];
    const float* peer_w_q = (const float*)d_in[33];
    const float* peer_keys = (const float*)d_in[34];
    const float* peer_u = (const float*)d_in[35];
    const float* peer_v = (const float*)d_in[36];
    const float* g_final = (const float*)d_in[37];
    float* out = (float*)d_out;
    const int GRID = 512;

    char* wp = (char*)d_ws;
    auto alloc = [&](size_t bytes) { char* r = wp; wp += (bytes + 255) & ~(size_t)255; return r; };
    float* H = (float*)alloc((size_t)T * D * 4);
    float* MOD = (float*)alloc((size_t)DEPTH * 2 * 6 * D * 4);
    float* A1 = (float*)alloc((size_t)T * D * 4);
    float* P = (float*)alloc((size_t)T * INW * 4);
    float* Y = (float*)alloc((size_t)2 * T * DS5 * 4);
    float* Z = (float*)alloc((size_t)T * DS5 * 4);
    float* ZG = (float*)alloc((size_t)T * DS5 * 4);
    float* GG = (float*)alloc((size_t)2 * T * DGK * 4);
    float* O = (float*)alloc((size_t)2 * T * DGV * 4);
    float* ZC = (float*)alloc((size_t)T * 1536 * 4);
    float* H2 = (float*)alloc((size_t)SEQ * HYH * 4);
    float* FL = (float*)alloc((size_t)SEQ * 1024 * 4);
    float* FC = (float*)alloc((size_t)CTX * 1024 * 4);
    float* MIX = (float*)alloc((size_t)T * D * 4);
    float* Q = (float*)alloc((size_t)T * D * 4);
    int* IDX = (int*)alloc((size_t)T * 128 * 4);
    float* GATE = (float*)alloc((size_t)T * 128 * 4);
    constexpr int INP = 5248;
    bf16_t* WinT = (bf16_t*)alloc((size_t)DEPTH * INP * D * 2);
    bf16_t* WoutT = (bf16_t*)alloc((size_t)DEPTH * D * D * 2);
    bf16_t* WqT = (bf16_t*)alloc((size_t)DEPTH * D * D * 2);
    bf16_t* WgluT = (bf16_t*)alloc((size_t)DEPTH * DS5 * DS5 * 2);
    bf16_t* A1b = (bf16_t*)alloc((size_t)T * D * 2);
    bf16_t* Zb = (bf16_t*)alloc((size_t)T * DS5 * 2);
    bf16_t* MIXb = (bf16_t*)alloc((size_t)T * D * 2);
    bf16_t* Ub = (bf16_t*)alloc((size_t)DEPTH * PEXP * D * 2);
    bf16_t* Vb = (bf16_t*)alloc((size_t)DEPTH * PEXP * D * 2);
    if ((size_t)(wp - (char*)d_ws) > ws_size) fprintf(stderr, "WS OVERFLOW %zu > %zu\n", (size_t)(wp - (char*)d_ws), ws_size);
    static bool attr_done = false;
    if (!attr_done) {
        attr_done = true;
        hipFuncSetAttribute((const void*)kw_gemm_f32, hipFuncAttributeMaxDynamicSharedMemorySize, GEMM_LDS);
        hipFuncSetAttribute((const void*)kw_gemm_resid, hipFuncAttributeMaxDynamicSharedMemorySize, GEMM_LDS);
        hipFuncSetAttribute((const void*)k_mega_test, hipFuncAttributeMaxDynamicSharedMemorySize, MEGA_LDS);
    }
    static int mega_grid = 0;
    if (!mega_grid) {
        int dev = 0, cus = 0, per_cu = 0;
        hipGetDevice(&dev);
        hipDeviceGetAttribute(&cus, hipDeviceAttributeMultiprocessorCount, dev);
        hipOccupancyMaxActiveBlocksPerMultiprocessor(&per_cu, (const void*)k_mega_test, NTHR, MEGA_LDS);
        mega_grid = cus * (per_cu < 2 ? per_cu : 2);
        if (mega_grid <= 0) mega_grid = 256;
    }
    unsigned* BAR = (unsigned*)alloc((size_t)XCD_BAR_WORDS * 4);
    bf16_t* PB = (bf16_t*)alloc((size_t)T * PBW * 2);
    float* ALPHA = (float*)alloc((size_t)T * 32 * 4);
    float2* LAM = (float2*)alloc((size_t)DEPTH * 2 * G5 * PS * 8);
    float2* BBAR = (float2*)alloc((size_t)DEPTH * 2 * G5 * PS * CG * 8);
    float2* CSt = (float2*)alloc((size_t)DEPTH * 2 * G5 * PS * CG * 8);
    float2* SE = (float2*)alloc((size_t)2 * G5 * S5NC * PS * 8);
    float2* HIN = (float2*)alloc((size_t)2 * G5 * S5NC * PS * 8);
    float* SLOC = (float*)alloc((size_t)GNS * 16 * GLA_UNIT_F * 4);
    float* SIN = (float*)alloc((size_t)GNS * 16 * GLA_UNIT_F * 4);
    float* DEC = (float*)alloc((size_t)GNS * 8 * 128 * 4);
    bf16_t* OGb = (bf16_t*)alloc((size_t)2 * T * DGV * 2);
    static bool attr3 = false;
    if (!attr3) {
        attr3 = true;
        hipFuncSetAttribute((const void*)kw_gla<0>, hipFuncAttributeMaxDynamicSharedMemorySize, GLA_LDS);
        hipFuncSetAttribute((const void*)kw_gla<1>, hipFuncAttributeMaxDynamicSharedMemorySize, GLA_LDS);
    }
    bf16_t* FILT = (bf16_t*)alloc((size_t)DEPTH * DHY * 16384 * 2);
    bf16_t* FILTC = (bf16_t*)alloc((size_t)DEPTH * DHY * 512 * 2);
    bf16_t* X0b = (bf16_t*)alloc((size_t)T * DHY * 2);
    bf16_t* STb = (bf16_t*)alloc((size_t)DHY * T * 2);
    bf16_t* YTb = (bf16_t*)alloc((size_t)DHY * T * 2);
    static bool attr4 = false;
    if (!attr4) {
        attr4 = true;
        hipFuncSetAttribute((const void*)kw_hy_filter, hipFuncAttributeMaxDynamicSharedMemorySize, HYF_LDS);
        hipFuncSetAttribute((const void*)kw_hy_conv, hipFuncAttributeMaxDynamicSharedMemorySize, HYC_LDS);
    }
    kw_hy_filter<<<GRID, NTHR, HYF_LDS, stream>>>(hy_f_w1, hy_f_b1, hy_f_w2, hy_f_b2, hy_f_w3, hy_f_freq, hy_decay, FILT, FILTC);
    static bool attr2 = false;
    if (!attr2) {
        attr2 = true;
        hipFuncSetAttribute((const void*)kw_gemm_inproj, hipFuncAttributeMaxDynamicSharedMemorySize, GEMM_LDS);
        hipFuncSetAttribute((const void*)kw_gemm_glu, hipFuncAttributeMaxDynamicSharedMemorySize, GEMM_LDS);
        hipFuncSetAttribute((const void*)kw_s5_scan<0>, hipFuncAttributeMaxDynamicSharedMemorySize, S5_LDS);
        hipFuncSetAttribute((const void*)kw_s5_scan<1>, hipFuncAttributeMaxDynamicSharedMemorySize, S5_LDS);
    }
    kw_s5_tables<<<GRID, NTHR, 0, stream>>>(s5_a_re, s5_a_im, s5_log_step, s5_b_re, s5_b_im, s5_c_re, s5_c_im, LAM, BBAR, CSt);
    kw_convert<<<GRID * 4, NTHR, 0, stream>>>(peer_u, Ub, (size_t)DEPTH * PEXP * D);
    kw_convert<<<GRID * 4, NTHR, 0, stream>>>(peer_v, Vb, (size_t)DEPTH * PEXP * D);
    for (int l = 0; l < DEPTH; ++l) {
        kw_wt_convert<1><<<GRID, NTHR, 64 * 65 * 4, stream>>>(w_in + (size_t)l * D * INW, D, INW, WinT + (size_t)l * INP * D, INP);
        kw_wt_convert<0><<<GRID, NTHR, 64 * 65 * 4, stream>>>(w_out + (size_t)l * D * D, D, D, WoutT + (size_t)l * D * D, D);
        kw_wt_convert<0><<<GRID, NTHR, 64 * 65 * 4, stream>>>(peer_w_q + (size_t)l * D * D, D, D, WqT + (size_t)l * D * D, D);
        kw_wt_convert<0><<<GRID, NTHR, 64 * 65 * 4, stream>>>(s5_w_glu + (size_t)l * DS5 * DS5, DS5, DS5, WgluT + (size_t)l * DS5 * DS5, DS5);
    }

    k_init_h<<<T, 256, 0, stream>>>(x, ctx, H);
    k_ada<<<dim3(6 * D / 256, DEPTH), 256, 0, stream>>>(c, c_ctx, w_ada, b_ada, MOD);

    for (int l = 0; l < DEPTH; ++l) {
        const float* MODl = MOD + (size_t)l * 2 * 6 * D;
        k_modulate<<<T, 256, 0, stream>>>(H, g_norm1 + (size_t)l * D, MODl, 0, D, A1);
        kw_modulate_bf16<<<GRID, NTHR, 0, stream>>>(H, g_norm1 + (size_t)l * D, MODl, 0, D, A1b);
        kw_gemm_inproj<<<GRID, NTHR, GEMM_LDS, stream>>>(A1b, WinT + (size_t)l * INP * D, PB, ALPHA, P);
        kw_s5_scan<0><<<GRID, NTHR, S5_LDS, stream>>>(l, PB, LAM, BBAR, CSt, s5_d + (size_t)l * DS5, SE, nullptr, nullptr, nullptr);
        kw_s5_carry<<<16, NTHR, 0, stream>>>(l, LAM, SE, HIN);
        kw_s5_scan<1><<<GRID, NTHR, S5_LDS, stream>>>(l, PB, LAM, BBAR, CSt, s5_d + (size_t)l * DS5, nullptr, HIN, Zb, nullptr);
        kw_gemm_glu<<<GRID, NTHR, GEMM_LDS, stream>>>(Zb, WgluT + (size_t)l * DS5 * DS5, s5_b_glu + (size_t)l * DS5, MIXb, MIX);
        kw_gla<0><<<GRID, NTHR, GLA_LDS, stream>>>(PB, ALPHA, gla_w_alpha + (size_t)l * 2 * RANK * DGK, gla_b_alpha + (size_t)l * 2 * DGK,
                                                   SLOC, DEC, nullptr, nullptr);
        kw_gla_carry<<<GRID, NTHR, 0, stream>>>(SLOC, DEC, SIN);
        kw_gla<1><<<GRID, NTHR, GLA_LDS, stream>>>(PB, ALPHA, gla_w_alpha + (size_t)l * 2 * RANK * DGK, gla_b_alpha + (size_t)l * 2 * DGK,
                                                   nullptr, nullptr, SIN, OGb);
        kw_gla_finish<<<GRID, NTHR, 0, stream>>>(PB, OGb, gla_g_norm + (size_t)l * DV, MIXb, MIX);
        kw_hy_short<<<GRID, NTHR, HYS_LDS, stream>>>(PB, hy_conv_w + (size_t)l * 3 * 1536, hy_conv_b + (size_t)l * 1536, X0b, STb);
        kw_hy_conv<<<GRID, NTHR, HYC_LDS, stream>>>(l, FILT, FILTC, STb, YTb);
        kw_hy_finish<<<GRID, NTHR, HYN_LDS, stream>>>(X0b, STb, YTb, hy_bias + (size_t)l * DHY, MIXb, MIX);
        kw_convert<<<GRID, NTHR, 0, stream>>>(MIX, MIXb, (size_t)T * D);
        kw_gemm_resid<<<GRID, NTHR, GEMM_LDS, stream>>>(MIXb, D, WoutT + (size_t)l * D * D, D, T / GBM, D / GBN, D, H, MODl, 2 * D);
        k_modulate<<<T, 256, 0, stream>>>(H, g_norm2 + (size_t)l * D, MODl, 3 * D, 4 * D, A1);
        kw_modulate_bf16<<<GRID, NTHR, 0, stream>>>(H, g_norm2 + (size_t)l * D, MODl, 3 * D, 4 * D, A1b);
        kw_gemm_f32<<<GRID, NTHR, GEMM_LDS, stream>>>(A1b, D, WqT + (size_t)l * D * D, D, T / GBM, D / GBN, D, Q, D, D);
        k_peer_select<<<dim3(T / 64, PH), 64, 0, stream>>>(Q, peer_keys + (size_t)l * PH * 2 * PKEYS * 128, IDX, GATE);
        kw_peer_gather<<<GRID, NTHR, 0, stream>>>(A1b, IDX, GATE, Ub + (size_t)l * PEXP * D, Vb + (size_t)l * PEXP * D, MODl, H);
    }
    k_final<<<SEQ, 256, 0, stream>>>(H, g_final, out);
}
```

```cpp
#include <hip/hip_runtime.h>
#include <math.h>
#include <stdint.h>
#include <stdio.h>

constexpr int D = 2048, SEQ = 8192, CTX = 256, T = SEQ + CTX, DEPTH = 4;
constexpr int DS5 = 512, G5 = 32, CG = 16, PS = 64;
constexpr int GH = 4, DK = 128, DV = 256, DGK = 512, DGV = 1024, RANK = 16;
constexpr int DHY = 512, HYF = 33, HYH = 64;
constexpr int INW = 5152;
constexpr int O_S5 = 0, O_Q = 512, O_K = 1024, O_V = 1536, O_GATE = 2560, O_ALPHA = 3584, O_HY = 3616;
constexpr int PH = 8, PKEYS = 128, PDQ = 256, PTOP = 16, PEXP = 16384;
constexpr float EPS = 1e-6f;

__device__ __forceinline__ float gelu_f(float x) {
    return 0.5f * x * (1.f + tanhf(0.7978845608028654f * (x + 0.044715f * x * x * x)));
}
__device__ __forceinline__ float sigmoid_f(float x) { return 1.f / (1.f + expf(-x)); }
__device__ __forceinline__ float silu_f(float x) { return x * sigmoid_f(x); }
__device__ __forceinline__ float logsigmoid_f(float x) { return fminf(x, 0.f) - log1pf(expf(-fabsf(x))); }

__device__ __forceinline__ float wave_sum(float v, int lane) {
#pragma unroll
    for (int o = 32; o > 0; o >>= 1) v += __int_as_float(__builtin_amdgcn_ds_bpermute((lane ^ o) << 2, __float_as_int(v)));
    return v;
}

__device__ __forceinline__ int ltid(int wv) {
    unsigned z = 0u;
    asm volatile("" : "+s"(z));
    int t = (wv << 6) | (int)__builtin_amdgcn_mbcnt_hi(~0u, __builtin_amdgcn_mbcnt_lo(~0u, z));
    asm volatile("" : "+v"(t));
    return t;
}


__device__ __forceinline__ int scan_row(int dr, int j) {
    return dr == 0 ? j : (j < CTX ? CTX - 1 - j : (T + CTX - 1) - j);
}

typedef unsigned short bf16_t;
typedef __attribute__((ext_vector_type(8))) short bf16x8;
typedef __attribute__((ext_vector_type(4))) float f32x4;
#define NTHR 256

__device__ __forceinline__ bf16_t f2bf(float f) {
    unsigned u = __float_as_uint(f);
    u += 0x7fffu + ((u >> 16) & 1u);
    return (bf16_t)(u >> 16);
}
__device__ __forceinline__ float bf2f(bf16_t b) { return __uint_as_float(((unsigned)b) << 16); }
__device__ __forceinline__ unsigned pack2bf(float lo, float hi) { return (unsigned)f2bf(lo) | ((unsigned)f2bf(hi) << 16); }

__device__ __forceinline__ int win_src_col(int n_out) {
    if (n_out < 3584) return n_out;
    if (n_out < 5120) return n_out + 32;
    if (n_out < 5152) return n_out - 1536;
    return -1;
}
template <int PERM>
__device__ __forceinline__ void phase_wt_convert(const float* __restrict__ W, int K, int N, bf16_t* __restrict__ Wt, int Nout, char* smem,
                                 int vb, int nb, int WV) {
    const int TIDX = ltid(WV);
    float* tile = (float*)smem;
    const int tilesN = Nout / 64, tilesK = K / 64, ntl = tilesN * tilesK;
    const int kq = TIDX >> 4, n4 = (TIDX & 15) * 4;
    float4 r0, r1, r2, r3;
#define WT_LOAD(TL)                                                                                             \
    {                                                                                                           \
        const int tn_ = (TL) / tilesK, tk_ = (TL) % tilesK, n_out = tn_ * 64 + n4;                              \
        const int src = PERM ? win_src_col(n_out) : (n_out < N ? n_out : -1);                                   \
        const float* wp = W + (size_t)(tk_ * 64 + kq) * N + (src >= 0 ? src : 0);                               \
        r0 = make_float4(0.f, 0.f, 0.f, 0.f); r1 = r0; r2 = r0; r3 = r0;                                        \
        if (src >= 0) {                                                                                         \
            { const f32x4 t0 = __builtin_nontemporal_load(reinterpret_cast<const f32x4*>(wp)); r0 = make_float4(t0[0], t0[1], t0[2], t0[3]); }                       \
            { const f32x4 t1 = __builtin_nontemporal_load(reinterpret_cast<const f32x4*>(wp + (size_t)16 * N)); r1 = make_float4(t1[0], t1[1], t1[2], t1[3]); }      \
            { const f32x4 t2 = __builtin_nontemporal_load(reinterpret_cast<const f32x4*>(wp + (size_t)32 * N)); r2 = make_float4(t2[0], t2[1], t2[2], t2[3]); }      \
            { const f32x4 t3 = __builtin_nontemporal_load(reinterpret_cast<const f32x4*>(wp + (size_t)48 * N)); r3 = make_float4(t3[0], t3[1], t3[2], t3[3]); }      \
        }                                                                                                       \
    }
    int t = vb;
    if (t < ntl) WT_LOAD(t)
    while (t < ntl) {
        const int tn = t / tilesK, tk = t % tilesK;
        __syncthreads();
        {
            float* tp = tile + kq * 65 + n4;
            tp[0] = r0.x; tp[1] = r0.y; tp[2] = r0.z; tp[3] = r0.w;
            tp[16 * 65 + 0] = r1.x; tp[16 * 65 + 1] = r1.y; tp[16 * 65 + 2] = r1.z; tp[16 * 65 + 3] = r1.w;
            tp[32 * 65 + 0] = r2.x; tp[32 * 65 + 1] = r2.y; tp[32 * 65 + 2] = r2.z; tp[32 * 65 + 3] = r2.w;
            tp[48 * 65 + 0] = r3.x; tp[48 * 65 + 1] = r3.y; tp[48 * 65 + 2] = r3.z; tp[48 * 65 + 3] = r3.w;
        }
        const int tnext = t + nb;
        if (tnext < ntl) WT_LOAD(tnext)
        __syncthreads();
#pragma unroll
        for (int h = 0; h < 2; ++h) {
            const int nn = (TIDX >> 3) + 32 * h, k8 = (TIDX & 7) * 8;
            const float* tp = tile + k8 * 65 + nn;
            uint4 o;
            o.x = pack2bf(tp[0 * 65], tp[1 * 65]); o.y = pack2bf(tp[2 * 65], tp[3 * 65]);
            o.z = pack2bf(tp[4 * 65], tp[5 * 65]); o.w = pack2bf(tp[6 * 65], tp[7 * 65]);
            *reinterpret_cast<uint4*>(Wt + (size_t)(tn * 64 + nn) * K + tk * 64 + k8) = o;
        }
        t = tnext;
    }
#undef WT_LOAD
}
__device__ __forceinline__ void phase_convert(const float* __restrict__ src, bf16_t* __restrict__ dst, size_t n, int vb, int nb, int WV) {
    const int TIDX = ltid(WV);
    size_t n4 = n / 4;
    for (size_t i = (size_t)vb * NTHR + TIDX; i < n4; i += (size_t)nb * NTHR) {
        float4 v = reinterpret_cast<const float4*>(src)[i];
        uint2 o; o.x = pack2bf(v.x, v.y); o.y = pack2bf(v.z, v.w);
        reinterpret_cast<uint2*>(dst)[i] = o;
    }
}

constexpr int GBM = 128, GBN = 128, GBK = 64, GLD = 72;
constexpr int GEMM_LDS = 2 * 2 * GBM * GLD * 2;

template <bool AF32>
__device__ __forceinline__ uint4 lda_chunk(const bf16_t* Ag, const float* Af, size_t off) {
    if (!AF32) return *reinterpret_cast<const uint4*>(Ag + off);
    const float4 lo = *reinterpret_cast<const float4*>(Af + off), hi = *reinterpret_cast<const float4*>(Af + off + 4);
    return make_uint4(pack2bf(lo.x, lo.y), pack2bf(lo.z, lo.w), pack2bf(hi.x, hi.y), pack2bf(hi.z, hi.w));
}
template <int ORD>
__device__ __forceinline__ void gemm_tile_coords(int i, int Mtiles, int& tm, int& tn) {
    if (ORD == 1) {
        if (i < 5 * 528) {
            const int stn = i / 528, r = i % 528;
            if (r < 512) { const int stm = r >> 6, w = r & 63; tm = stm * 8 + (w & 7); tn = stn * 8 + (w >> 3); }
            else { const int w = r - 512; tm = 64 + (w & 1); tn = stn * 8 + (w >> 1); }
        } else { tm = i - 5 * 528; tn = 40; }
    } else if (ORD == 2) {
        const int stn = i / 704, r = i % 704, stm = r >> 6, w = r & 63;
        tm = stm * 8 + (w & 7); tn = stn * 8 + (w >> 3);
    } else { tn = i / Mtiles; tm = i % Mtiles; }
}
template <bool AF32, int BMT, int ORD, class Epi>
__device__ __forceinline__ void gemm_phase_t(const bf16_t* __restrict__ A, int lda, const bf16_t* __restrict__ Bt, int ldb, int Mtiles,
                           int Ntiles, int K, char* smem, int vb, int nb, int WV, Epi epi) {
    const int TIDX = ltid(WV);
    constexpr int MI = BMT / 32;
    bf16_t* lds = (bf16_t*)smem;
    const int tid = TIDX, wave = tid >> 6, lane = tid & 63, lr = lane & 15, lq = lane >> 4;
    const int wm = wave >> 1, wn = wave & 1;
    const int ldrow = tid >> 3, ldk = (tid & 7) * 8;
    const int KT = K / GBK;
    const int ntiles = Mtiles * Ntiles;
    const int per_x = (ntiles + 7) >> 3, xq = vb >> 3, xstride = nb >> 3;
    const int t_begin = ORD ? (vb & 7) * per_x + xq : vb;
    const int t_end = ORD ? (((vb & 7) + 1) * per_x < ntiles ? ((vb & 7) + 1) * per_x : ntiles) : ntiles;
    const int t_step = ORD ? xstride : nb;
    for (int tile = t_begin; tile < t_end; tile += t_step) {
        int tm, tn;
        gemm_tile_coords<ORD>(tile, Mtiles, tm, tn);
        const bf16_t* Ag = A + (size_t)(tm * BMT + ldrow) * lda + ldk;
        const float* Af = reinterpret_cast<const float*>(A) + (size_t)(tm * BMT + ldrow) * lda + ldk;
        const bf16_t* Bg = Bt + (size_t)(tn * GBN + ldrow) * ldb + ldk;
        f32x4 acc[MI][4];
#pragma unroll
        for (int i = 0; i < MI; ++i)
#pragma unroll
            for (int j = 0; j < 4; ++j) acc[i][j] = (f32x4){0.f, 0.f, 0.f, 0.f};
        uint4 xa0, xa1, xa2, xa3, xb0, xb1, xb2, xb3, ya0, ya1, ya2, ya3, yb0, yb1, yb2, yb3;
        xa3 = make_uint4(0u, 0u, 0u, 0u); ya3 = xa3; xa2 = xa3; ya2 = xa3;
#define G_LOAD(P, KOFF)                                                                        \
        P##a0 = lda_chunk<AF32>(Ag, Af, (size_t)(0) * lda + (KOFF));                           \
        P##a1 = lda_chunk<AF32>(Ag, Af, (size_t)(32) * lda + (KOFF));                          \
        if (MI >= 3) P##a2 = lda_chunk<AF32>(Ag, Af, (size_t)(64) * lda + (KOFF));             \
        if (MI == 4) P##a3 = lda_chunk<AF32>(Ag, Af, (size_t)(96) * lda + (KOFF));             \
        P##b0 = *reinterpret_cast<const uint4*>(Bg + (size_t)(0) * ldb + (KOFF));              \
        P##b1 = *reinterpret_cast<const uint4*>(Bg + (size_t)(32) * ldb + (KOFF));             \
        P##b2 = *reinterpret_cast<const uint4*>(Bg + (size_t)(64) * ldb + (KOFF));             \
        P##b3 = *reinterpret_cast<const uint4*>(Bg + (size_t)(96) * ldb + (KOFF));
#define G_STORE(P, BUF)                                                                                    \
        *reinterpret_cast<uint4*>(lds + (((BUF) * 2 + 0) * GBM + ldrow + 0) * GLD + ldk) = P##a0;          \
        *reinterpret_cast<uint4*>(lds + (((BUF) * 2 + 0) * GBM + ldrow + 32) * GLD + ldk) = P##a1;         \
        if (MI >= 3) *reinterpret_cast<uint4*>(lds + (((BUF) * 2 + 0) * GBM + ldrow + 64) * GLD + ldk) = P##a2; \
        if (MI == 4) *reinterpret_cast<uint4*>(lds + (((BUF) * 2 + 0) * GBM + ldrow + 96) * GLD + ldk) = P##a3; \
        *reinterpret_cast<uint4*>(lds + (((BUF) * 2 + 1) * GBM + ldrow + 0) * GLD + ldk) = P##b0;          \
        *reinterpret_cast<uint4*>(lds + (((BUF) * 2 + 1) * GBM + ldrow + 32) * GLD + ldk) = P##b1;         \
        *reinterpret_cast<uint4*>(lds + (((BUF) * 2 + 1) * GBM + ldrow + 64) * GLD + ldk) = P##b2;         \
        *reinterpret_cast<uint4*>(lds + (((BUF) * 2 + 1) * GBM + ldrow + 96) * GLD + ldk) = P##b3;
#define G_COMPUTE(BUF)                                                                                     \
        {                                                                                                  \
            const bf16_t* As = lds + ((BUF) * 2 + 0) * GBM * GLD;                                          \
            const bf16_t* Bs = lds + ((BUF) * 2 + 1) * GBM * GLD;                                          \
            _Pragma("unroll") for (int ks = 0; ks < 2; ++ks) {                                             \
                bf16x8 af[MI], bfr[4];                                                                     \
                _Pragma("unroll") for (int i = 0; i < MI; ++i)                                             \
                    af[i] = *reinterpret_cast<const bf16x8*>(As + (wm * (BMT / 2) + i * 16 + lr) * GLD + ks * 32 + lq * 8); \
                _Pragma("unroll") for (int i = 0; i < 4; ++i)                                              \
                    bfr[i] = *reinterpret_cast<const bf16x8*>(Bs + (wn * 64 + i * 16 + lr) * GLD + ks * 32 + lq * 8);       \
                _Pragma("unroll") for (int i = 0; i < MI; ++i)                                             \
                    _Pragma("unroll") for (int j = 0; j < 4; ++j)                                          \
                        acc[i][j] = __builtin_amdgcn_mfma_f32_16x16x32_bf16(af[i], bfr[j], acc[i][j], 0, 0, 0);             \
            }                                                                                              \
        }
        G_LOAD(x, 0)
        G_LOAD(y, GBK)
        __syncthreads();
        G_STORE(x, 0)
        __syncthreads();
        for (int kt = 0; kt + 2 < KT; kt += 2) {
            G_LOAD(x, (kt + 2) * GBK)
            G_COMPUTE(0)
            G_STORE(y, 1)
            __syncthreads();
            G_LOAD(y, (kt + 3) * GBK)
            G_COMPUTE(1)
            G_STORE(x, 0)
            __syncthreads();
        }
        G_COMPUTE(0)
        G_STORE(y, 1)
        __syncthreads();
        G_COMPUTE(1)
#undef G_LOAD
#undef G_STORE
#undef G_COMPUTE
#pragma unroll
        for (int i = 0; i < MI; ++i)
#pragma unroll
            for (int j = 0; j < 4; ++j)
                epi(tm * BMT + wm * (BMT / 2) + i * 16 + lq * 4, tn * GBN + wn * 64 + j * 16 + lr, acc[i][j]);
    }
    __syncthreads();
}

template <class Epi>
__device__ __forceinline__ void gemm_phase(const bf16_t* A, int lda, const bf16_t* Bt, int ldb, int Mtiles, int Ntiles, int K,
                                           char* smem, int vb, int nb, int WV, Epi epi) {
    gemm_phase_t<false, 128, 0>(A, lda, Bt, ldb, Mtiles, Ntiles, K, smem, vb, nb, WV, epi);
}
struct EpiF32 {
    float* C; int ldc; int N;
    __device__ __forceinline__ void operator()(int m, int n, const f32x4& a) const {
        if (n < N) {
#pragma unroll
            for (int r = 0; r < 4; ++r) C[(size_t)(m + r) * ldc + n] = a[r];
        }
    }
};
struct EpiResid {
    float* H; const float* MODl; int gate_off;
    __device__ __forceinline__ void operator()(int m, int n, const f32x4& a) const {
        const float gt = MODl[(size_t)(m < CTX ? 1 : 0) * 6 * D + gate_off + n];
#pragma unroll
        for (int r = 0; r < 4; ++r) H[(size_t)(m + r) * D + n] += gt * a[r];
    }
};

__device__ __forceinline__ void phase_modulate_bf16(const float* __restrict__ H, const float* __restrict__ g, const float* __restrict__ MODl,
                                    int shift_off, int scale_off, bf16_t* __restrict__ OUT, int vb, int nb, int WV) {
    const int TIDX = ltid(WV);
    const int wave = TIDX >> 6, lane = TIDX & 63;
    for (int row = vb * 4 + wave; row < T; row += nb * 4) {
        const float* h = H + (size_t)row * D;
        float4 v[8];
        float ss = 0.f;
#pragma unroll
        for (int i = 0; i < 8; ++i) {
            v[i] = *reinterpret_cast<const float4*>(h + i * 256 + lane * 4);
            ss += v[i].x * v[i].x + v[i].y * v[i].y + v[i].z * v[i].z + v[i].w * v[i].w;
        }
        ss = wave_sum(ss, lane);
        const float rs = rsqrtf(ss / D + EPS);
        const float* m = MODl + (size_t)(row < CTX ? 1 : 0) * 6 * D;
#pragma unroll
        for (int i = 0; i < 8; ++i) {
            const int d = i * 256 + lane * 4;
            const float4 gg = *reinterpret_cast<const float4*>(g + d);
            const float4 sc = *reinterpret_cast<const float4*>(m + scale_off + d);
            const float4 sh = *reinterpret_cast<const float4*>(m + shift_off + d);
            uint2 o;
            o.x = pack2bf(v[i].x * rs * gg.x * (1.f + sc.x) + sh.x, v[i].y * rs * gg.y * (1.f + sc.y) + sh.y);
            o.y = pack2bf(v[i].z * rs * gg.z * (1.f + sc.z) + sh.z, v[i].w * rs * gg.w * (1.f + sc.w) + sh.w);
            *reinterpret_cast<uint2*>(OUT + (size_t)row * D + d) = o;
        }
    }
}


__device__ __forceinline__ float bflo(unsigned w) { return __uint_as_float(w << 16); }
__device__ __forceinline__ float bfhi(unsigned w) { return __uint_as_float(w & 0xffff0000u); }
__device__ __forceinline__ float dot8(const uint4& u, const float* xf) {
    return bflo(u.x) * xf[0] + bfhi(u.x) * xf[1] + bflo(u.y) * xf[2] + bfhi(u.y) * xf[3] + bflo(u.z) * xf[4] + bfhi(u.z) * xf[5] +
           bflo(u.w) * xf[6] + bfhi(u.w) * xf[7];
}
__device__ __forceinline__ void axpy8(const uint4& v, float w, float* o) {
    o[0] += w * bflo(v.x); o[1] += w * bfhi(v.x); o[2] += w * bflo(v.y); o[3] += w * bfhi(v.y);
    o[4] += w * bflo(v.z); o[5] += w * bfhi(v.z); o[6] += w * bflo(v.w); o[7] += w * bfhi(v.w);
}
constexpr float PEER_USCALE = 512.f;
__device__ __forceinline__ unsigned cvt4_fp8(f32x4 v, float scale) {
    const float a = __builtin_amdgcn_fmed3f(v[0] * scale, -448.f, 448.f), b = __builtin_amdgcn_fmed3f(v[1] * scale, -448.f, 448.f);
    const float c = __builtin_amdgcn_fmed3f(v[2] * scale, -448.f, 448.f), d = __builtin_amdgcn_fmed3f(v[3] * scale, -448.f, 448.f);
    int w = __builtin_amdgcn_cvt_pk_fp8_f32(a, b, 0, false);
    w = __builtin_amdgcn_cvt_pk_fp8_f32(c, d, w, true);
    return (unsigned)w;
}
__device__ __forceinline__ void phase_convert_fp8(const float* __restrict__ src, unsigned* __restrict__ dst, size_t n, float scale,
                                                  int vb, int nb, int WV) {
    const int TIDX = ltid(WV);
    const int nchunk = (int)(n / (4 * 8 * NTHR));
    for (int ch = vb; ch < nchunk; ch += nb) {
        const f32x4* sp = reinterpret_cast<const f32x4*>(src) + (size_t)ch * (8 * NTHR) + TIDX;
        unsigned* dp = dst + (size_t)ch * (8 * NTHR) + TIDX;
        const f32x4 v0 = __builtin_nontemporal_load(sp + 0 * NTHR), v1 = __builtin_nontemporal_load(sp + 1 * NTHR);
        const f32x4 v2 = __builtin_nontemporal_load(sp + 2 * NTHR), v3 = __builtin_nontemporal_load(sp + 3 * NTHR);
        const f32x4 v4 = __builtin_nontemporal_load(sp + 4 * NTHR), v5 = __builtin_nontemporal_load(sp + 5 * NTHR);
        const f32x4 v6 = __builtin_nontemporal_load(sp + 6 * NTHR), v7 = __builtin_nontemporal_load(sp + 7 * NTHR);
        dp[0 * NTHR] = cvt4_fp8(v0, scale); dp[1 * NTHR] = cvt4_fp8(v1, scale); dp[2 * NTHR] = cvt4_fp8(v2, scale);
        dp[3 * NTHR] = cvt4_fp8(v3, scale); dp[4 * NTHR] = cvt4_fp8(v4, scale); dp[5 * NTHR] = cvt4_fp8(v5, scale);
        dp[6 * NTHR] = cvt4_fp8(v6, scale); dp[7 * NTHR] = cvt4_fp8(v7, scale);
    }
}
typedef float f32x2_t __attribute__((ext_vector_type(2)));
typedef float v16f_t __attribute__((ext_vector_type(16)));
typedef float v32f_t __attribute__((ext_vector_type(32)));
typedef unsigned v6u_t __attribute__((ext_vector_type(6)));
constexpr int PROW = 1024;
constexpr float PEER_US6 = 90.5f, PEER_VS6 = 2.0f;
#ifndef F6_INTERLEAVED
#define F6_INTERLEAVED 0
#endif
__host__ __device__ constexpr int f6_q(int i) { return F6_INTERLEAVED ? ((i & 1) ? 16 + (i >> 1) : (i >> 1)) : i; }
__device__ __forceinline__ void phase_convert_fp6(const float* __restrict__ src, unsigned char* __restrict__ dst, int nrows, float scale,
                                                  int vb, int nb, int WV) {
    const int TIDX = ltid(WV);
    const int lane = TIDX & 63;
    for (int row = vb * 4 + WV; row < nrows; row += nb * 4) {
        const f32x4* sp = reinterpret_cast<const f32x4*>(src + (size_t)row * D) + lane;
        f32x4 q[8];
#pragma unroll
        for (int g = 0; g < 8; ++g) q[g] = __builtin_nontemporal_load(sp + g * 64);
        unsigned w[4] = {0u, 0u, 0u, 0u};
#pragma unroll
        for (int g = 0; g < 8; ++g) {
            const float c0 = __builtin_amdgcn_fmed3f(q[g][0] * scale, -6.f, 6.f), c1 = __builtin_amdgcn_fmed3f(q[g][1] * scale, -6.f, 6.f);
            const float c2 = __builtin_amdgcn_fmed3f(q[g][2] * scale, -6.f, 6.f), c3 = __builtin_amdgcn_fmed3f(q[g][3] * scale, -6.f, 6.f);
            if (g & 1) {
                w[g >> 1] = __builtin_amdgcn_cvt_scalef32_pk_fp4_f32(w[g >> 1], c0, c1, 1.0f, 2);
                w[g >> 1] = __builtin_amdgcn_cvt_scalef32_pk_fp4_f32(w[g >> 1], c2, c3, 1.0f, 3);
            } else {
                w[g >> 1] = __builtin_amdgcn_cvt_scalef32_pk_fp4_f32(w[g >> 1], c0, c1, 1.0f, 0);
                w[g >> 1] = __builtin_amdgcn_cvt_scalef32_pk_fp4_f32(w[g >> 1], c2, c3, 1.0f, 1);
            }
        }
        *reinterpret_cast<uint4*>(dst + (size_t)row * PROW + lane * 16) = make_uint4(w[0], w[1], w[2], w[3]);
    }
}
typedef uint4 prow_t;
__device__ __forceinline__ prow_t ld_f6(const unsigned char* p) { return *reinterpret_cast<const uint4*>(p); }
__device__ __forceinline__ float dot32_f6(const prow_t& u, const float (&xp)[32]) {
    const unsigned w[4] = {u.x, u.y, u.z, u.w};
    f32x2_t s2 = (f32x2_t){0.f, 0.f};
#pragma unroll
    for (int j = 0; j < 4; ++j) {
        s2 += __builtin_amdgcn_cvt_scalef32_pk_f32_fp4(w[j], 1.0f, 0) * (f32x2_t){xp[j * 8 + 0], xp[j * 8 + 1]};
        s2 += __builtin_amdgcn_cvt_scalef32_pk_f32_fp4(w[j], 1.0f, 1) * (f32x2_t){xp[j * 8 + 2], xp[j * 8 + 3]};
        s2 += __builtin_amdgcn_cvt_scalef32_pk_f32_fp4(w[j], 1.0f, 2) * (f32x2_t){xp[j * 8 + 4], xp[j * 8 + 5]};
        s2 += __builtin_amdgcn_cvt_scalef32_pk_f32_fp4(w[j], 1.0f, 3) * (f32x2_t){xp[j * 8 + 6], xp[j * 8 + 7]};
    }
    return s2[0] + s2[1];
}
__device__ __forceinline__ void axpy32_f6(const prow_t& v, float wgt, float (&o)[32]) {
    const unsigned w[4] = {v.x, v.y, v.z, v.w};
#pragma unroll
    for (int j = 0; j < 4; ++j) {
#pragma unroll
        for (int b = 0; b < 4; ++b) {
            f32x2_t d;
            if (b == 0) d = __builtin_amdgcn_cvt_scalef32_pk_f32_fp4(w[j], 1.0f, 0);
            else if (b == 1) d = __builtin_amdgcn_cvt_scalef32_pk_f32_fp4(w[j], 1.0f, 1);
            else if (b == 2) d = __builtin_amdgcn_cvt_scalef32_pk_f32_fp4(w[j], 1.0f, 2);
            else d = __builtin_amdgcn_cvt_scalef32_pk_f32_fp4(w[j], 1.0f, 3);
            o[j * 8 + b * 2 + 0] += wgt * d[0];
            o[j * 8 + b * 2 + 1] += wgt * d[1];
        }
    }
}
__device__ __forceinline__ float dot16_fp8(const uint4& u, const float* xf) {
    const unsigned w[4] = {u.x, u.y, u.z, u.w};
    f32x2_t s2 = (f32x2_t){0.f, 0.f};
#pragma unroll
    for (int q = 0; q < 4; ++q) {
        const f32x2_t lo = __builtin_amdgcn_cvt_pk_f32_fp8((int)w[q], false);
        const f32x2_t hi = __builtin_amdgcn_cvt_pk_f32_fp8((int)w[q], true);
        s2 += lo * (f32x2_t){xf[q * 4 + 0], xf[q * 4 + 1]};
        s2 += hi * (f32x2_t){xf[q * 4 + 2], xf[q * 4 + 3]};
    }
    return s2[0] + s2[1];
}
__device__ __forceinline__ void axpy16_fp8(const uint4& v, float wgt, float* o) {
    const unsigned w[4] = {v.x, v.y, v.z, v.w};
#pragma unroll
    for (int q = 0; q < 4; ++q) {
        const auto lo = __builtin_amdgcn_cvt_pk_f32_fp8((int)w[q], false);
        const auto hi = __builtin_amdgcn_cvt_pk_f32_fp8((int)w[q], true);
        o[q * 4 + 0] += wgt * lo[0]; o[q * 4 + 1] += wgt * lo[1]; o[q * 4 + 2] += wgt * hi[0]; o[q * 4 + 3] += wgt * hi[1];
    }
}
__device__ __forceinline__ void peer_sort128(unsigned& k0, unsigned& k1, int lane) {
#pragma unroll
    for (int k = 2; k <= 128; k <<= 1) {
#pragma unroll
        for (int j = k >> 1; j > 0; j >>= 1) {
            if (j == 64) {
                const unsigned lo = k0 < k1 ? k0 : k1, hi = k0 < k1 ? k1 : k0;
                k0 = lo; k1 = hi;
            } else {
                const bool lower = (lane & j) == 0;
                const bool asc0 = k < 64 ? (lane & k) == 0 : true;
                const bool asc1 = k < 64 ? (lane & k) == 0 : (k == 64 ? false : true);
                const unsigned o0 = (unsigned)__builtin_amdgcn_ds_bpermute((lane ^ j) << 2, (int)k0);
                const unsigned o1 = (unsigned)__builtin_amdgcn_ds_bpermute((lane ^ j) << 2, (int)k1);
                const unsigned mn0 = k0 < o0 ? k0 : o0, mx0 = k0 < o0 ? o0 : k0;
                const unsigned mn1 = k1 < o1 ? k1 : o1, mx1 = k1 < o1 ? o1 : k1;
                k0 = (lower == asc0) ? mn0 : mx0;
                k1 = (lower == asc1) ? mn1 : mx1;
            }
        }
    }
}
template <bool MORE>
__device__ __forceinline__ void peer_batch(const unsigned char* __restrict__ U8, const unsigned char* __restrict__ V8, int e0, int lane,
                                           int id0, int id1, float g0, float g1, const float (&xf)[32], float (&acc)[32],
                                           prow_t (&ur)[4], prow_t (&vr)[4], int (&cur)[4]) {
    float a[4];
#pragma unroll
    for (int k = 0; k < 4; ++k) a[k] = dot32_f6(ur[k], xf);
    int idn[4] = {0, 0, 0, 0};
    if (MORE) {
#pragma unroll
        for (int k = 0; k < 4; ++k) {
            const int e = e0 + 4 + k;
            idn[k] = __builtin_amdgcn_readlane(e < 64 ? id0 : id1, e & 63);
            ur[k] = ld_f6(U8 + (size_t)(idn[k] >> 7) * PROW + lane * 16);
        }
    }
    const bool b5 = (lane & 32) != 0, b4 = (lane & 16) != 0;
    const float r0 = (b5 ? a[2] : a[0]) + __int_as_float(__builtin_amdgcn_ds_bpermute((lane ^ 32) << 2, __float_as_int(b5 ? a[0] : a[2])));
    const float r1 = (b5 ? a[3] : a[1]) + __int_as_float(__builtin_amdgcn_ds_bpermute((lane ^ 32) << 2, __float_as_int(b5 ? a[1] : a[3])));
    float v = (b4 ? r1 : r0) + __int_as_float(__builtin_amdgcn_ds_bpermute((lane ^ 16) << 2, __float_as_int(b4 ? r0 : r1)));
#pragma unroll
    for (int o = 8; o > 0; o >>= 1) v += __int_as_float(__builtin_amdgcn_ds_bpermute((lane ^ o) << 2, __float_as_int(v)));
    const int wv = __float_as_int(gelu_f(v * (1.f / PEER_US6)) * (1.f / PEER_VS6));
#pragma unroll
    for (int k = 0; k < 4; ++k) {
        const int slot = cur[k] & 127;
        const float gk = __int_as_float(__builtin_amdgcn_readlane(__float_as_int(slot < 64 ? g0 : g1), slot & 63));
        const float w = gk * __int_as_float(__builtin_amdgcn_readlane(wv, 16 * k));
        axpy32_f6(vr[k], w, acc);
        if (MORE) {
            vr[k] = ld_f6(V8 + (size_t)(idn[k] >> 7) * PROW + lane * 16);
            cur[k] = idn[k];
        }
    }
}
__device__ __forceinline__ void peer_experts(const bf16_t* X, const int* __restrict__ IDX, const float* __restrict__ GATE,
                                             const unsigned char* __restrict__ U8, const unsigned char* __restrict__ V8, int tok, int lane,
                                             int EB, int NE, float (&acc)[32]) {
    float xq[32];
#pragma unroll
    for (int g = 0; g < 8; ++g) {
        typedef unsigned u32x2nt_t __attribute__((ext_vector_type(2)));
        const u32x2nt_t xr2 = __builtin_nontemporal_load(reinterpret_cast<const u32x2nt_t*>(X + (size_t)tok * D + g * 256 + lane * 4));
        const uint2 xr = make_uint2(xr2[0], xr2[1]);
        xq[g * 4 + 0] = bflo(xr.x); xq[g * 4 + 1] = bfhi(xr.x); xq[g * 4 + 2] = bflo(xr.y); xq[g * 4 + 3] = bfhi(xr.y);
    }
    float xf[32];
#pragma unroll
    for (int i = 0; i < 32; ++i) xf[i] = xq[f6_q(i)];
#pragma unroll
    for (int i = 0; i < 32; ++i) acc[i] = 0.f;
    const size_t io0 = (size_t)tok * 128 + lane, io1 = io0 + 64;
    const float g0 = GATE[io0], g1 = GATE[io1];
    unsigned sk0 = ((unsigned)IDX[io0] << 7) | (unsigned)lane, sk1 = ((unsigned)IDX[io1] << 7) | (unsigned)(lane + 64);
    peer_sort128(sk0, sk1, lane);
    const int id0 = (int)sk0, id1 = (int)sk1;
    prow_t ur[4], vr[4];
    int cur[4];
#pragma unroll
    for (int k = 0; k < 4; ++k) {
        const int e = EB + k;
        cur[k] = __builtin_amdgcn_readlane(e < 64 ? id0 : id1, e & 63);
        ur[k] = ld_f6(U8 + (size_t)(cur[k] >> 7) * PROW + lane * 16);
        vr[k] = ld_f6(V8 + (size_t)(cur[k] >> 7) * PROW + lane * 16);
    }
#pragma unroll 1
    for (int e0 = EB; e0 < EB + NE - 4; e0 += 4) peer_batch<true>(U8, V8, e0, lane, id0, id1, g0, g1, xf, acc, ur, vr, cur);
    peer_batch<false>(U8, V8, EB + NE - 4, lane, id0, id1, g0, g1, xf, acc, ur, vr, cur);
}
__host__ __device__ constexpr int f6_i(int q) { return F6_INTERLEAVED ? (q < 16 ? 2 * q : 2 * (q - 16) + 1) : q; }
__device__ __forceinline__ void peer_finish(int tok, int lane, float (&acc)[32], const float* __restrict__ MODl, float* H, bool last,
                                            const float* gnext, const float* MODnext, bf16_t* A1next, const float* gfin, float* out) {
    const int cls = tok < CTX ? 1 : 0;
    const float* gt2 = MODl + (size_t)cls * 6 * D + 5 * D;
    float* h = H + (size_t)tok * D;
    float ss = 0.f;
    float hn[32];
#pragma unroll
    for (int g = 0; g < 8; ++g) {
        const int d = g * 256 + lane * 4;
        const f32x4 hv4 = __builtin_nontemporal_load(reinterpret_cast<const f32x4*>(h + d));
        float4 hv = make_float4(hv4[0], hv4[1], hv4[2], hv4[3]);
        const float4 gv = *reinterpret_cast<const float4*>(gt2 + d);
        hv.x += gv.x * acc[f6_i(g * 4 + 0)]; hv.y += gv.y * acc[f6_i(g * 4 + 1)];
        hv.z += gv.z * acc[f6_i(g * 4 + 2)]; hv.w += gv.w * acc[f6_i(g * 4 + 3)];
        __builtin_nontemporal_store((f32x4){hv.x, hv.y, hv.z, hv.w}, reinterpret_cast<f32x4*>(h + d));
        hn[g * 4 + 0] = hv.x; hn[g * 4 + 1] = hv.y; hn[g * 4 + 2] = hv.z; hn[g * 4 + 3] = hv.w;
        ss += hv.x * hv.x + hv.y * hv.y + hv.z * hv.z + hv.w * hv.w;
    }
    ss = wave_sum(ss, lane);
    const float rs = rsqrtf(ss / D + EPS);
    if (!last) {
        const float* m = MODnext + (size_t)cls * 6 * D;
#pragma unroll
        for (int g = 0; g < 8; ++g) {
            const int d = g * 256 + lane * 4;
            const float4 gg = *reinterpret_cast<const float4*>(gnext + d);
            const float4 sc = *reinterpret_cast<const float4*>(m + D + d);
            const float4 sh = *reinterpret_cast<const float4*>(m + d);
            const float* hv = hn + g * 4;
            uint2 o;
            o.x = pack2bf(hv[0] * rs * gg.x * (1.f + sc.x) + sh.x, hv[1] * rs * gg.y * (1.f + sc.y) + sh.y);
            o.y = pack2bf(hv[2] * rs * gg.z * (1.f + sc.z) + sh.z, hv[3] * rs * gg.w * (1.f + sc.w) + sh.w);
            typedef unsigned u32x2st_t __attribute__((ext_vector_type(2)));
            __builtin_nontemporal_store((u32x2st_t){o.x, o.y}, reinterpret_cast<u32x2st_t*>(A1next + (size_t)tok * D + d));
        }
    } else if (tok >= CTX) {
#pragma unroll
        for (int g = 0; g < 8; ++g) {
            const int d = g * 256 + lane * 4;
            const float4 gg = *reinterpret_cast<const float4*>(gfin + d);
            const float* hv = hn + g * 4;
            float4 o;
            o.x = hv[0] * rs * gg.x; o.y = hv[1] * rs * gg.y; o.z = hv[2] * rs * gg.z; o.w = hv[3] * rs * gg.w;
            __builtin_nontemporal_store((f32x4){o.x, o.y, o.z, o.w}, reinterpret_cast<f32x4*>(out + (size_t)(tok - CTX) * D + d));
        }
    }
}
__device__ __forceinline__ void phase_peer_gather(const bf16_t* X, const int* __restrict__ IDX, const float* __restrict__ GATE,
                                                  const unsigned char* __restrict__ U8, const unsigned char* __restrict__ V8,
                                                  const float* __restrict__ MODl, float* H, bool last, const float* gnext,
                                                  const float* MODnext, bf16_t* A1next, const float* gfin, float* out, char* smem, int vb, int nb,
                                                  int WV) {
    const int TIDX = ltid(WV);
    const int wave = TIDX >> 6, lane = TIDX & 63;
    for (int tok = vb * 4 + wave; tok < T; tok += nb * 4) {
        float acc[32];
        int ln = lane;
        asm volatile("" : "+v"(ln));
        peer_experts(X, IDX, GATE, U8, V8, tok, ln, 0, 128, acc);
        asm volatile("" : "+v"(ln));
        peer_finish(tok, ln, acc, MODl, H, last, gnext, MODnext, A1next, gfin, out);
    }
}

constexpr int PBW = 5120, PB_S5 = 0, PB_Q = 512, PB_K = 1024, PB_V = 1536, PB_GATE = 2560, PB_HY = 3584;
struct EpiInProj {
    bf16_t* PB; float* ALPHA; float* Pdev;
    __device__ __forceinline__ void operator()(int m, int n, const f32x4& a) const {
        if (n < PBW) {
#pragma unroll
            for (int r = 0; r < 4; ++r) PB[(size_t)(m + r) * PBW + n] = f2bf(a[r]);
        } else if (n < PBW + 32) {
#pragma unroll
            for (int r = 0; r < 4; ++r) ALPHA[(size_t)(m + r) * 32 + (n - PBW)] = a[r];
        }
        if (Pdev) {
            const int sc = win_src_col(n);
            if (sc >= 0) {
#pragma unroll
                for (int r = 0; r < 4; ++r) Pdev[(size_t)(m + r) * INW + sc] = a[r];
            }
        }
    }
};
struct EpiGLU {
    const float* Zf; const float* b; bf16_t* MIXb; float* MIXdev;
    __device__ __forceinline__ void operator()(int m, int n, const f32x4& a) const {
        const float bb = b[n];
#pragma unroll
        for (int r = 0; r < 4; ++r) {
            const float z = Zf[(size_t)(m + r) * DS5 + n];
            const float o = z * sigmoid_f(a[r] + bb);
            MIXb[(size_t)(m + r) * D + n] = f2bf(o);
            if (MIXdev) MIXdev[(size_t)(m + r) * D + n] = o;
        }
    }
};

constexpr int S5C = 64, S5NC = T / S5C;
__device__ __forceinline__ void phase_s5_tables(const float* a_re, const float* a_im, const float* log_step, const float* b_re,
                                                const float* b_im, const float* c_re, const float* c_im, float2* LAM,
                                                float2* BBAR, float2* CS, bf16_t* CMb, bf16_t* BBb, int vb, int nb, int WV) {
    const int TIDX = ltid(WV);
    for (int i = vb * NTHR + TIDX; i < DEPTH * 2 * G5 * PS; i += nb * NTHR) {
        const int p = i % PS, ldg = i / PS;
        const float ar = a_re[i], ai = a_im[i];
        const float dt = expf(log_step[ldg]);
        const float er = expf(ar * dt);
        const float lbr = er * cosf(ai * dt), lbi = er * sinf(ai * dt);
        const float nr = lbr - 1.f, ni = lbi, den = ar * ar + ai * ai;
        const float cfr = (nr * ar + ni * ai) / den, cfi = (ni * ar - nr * ai) / den;
        LAM[i] = make_float2(lbr, lbi);
        for (int c = 0; c < CG; ++c) {
            const float br = b_re[(size_t)i * CG + c], bi = b_im[(size_t)i * CG + c];
            BBAR[(size_t)i * CG + c] = make_float2(cfr * br - cfi * bi, cfr * bi + cfi * br);
            BBb[((size_t)ldg * 128 + p) * 32 + c] = f2bf(cfr * br - cfi * bi);
            BBb[((size_t)ldg * 128 + 64 + p) * 32 + c] = f2bf(cfr * bi + cfi * br);
            BBb[((size_t)ldg * 128 + p) * 32 + 16 + c] = 0;
            BBb[((size_t)ldg * 128 + 64 + p) * 32 + 16 + c] = 0;
            const size_t ci = ((size_t)ldg * CG + c) * PS + p;
            CS[(size_t)i * CG + c] = make_float2(c_re[ci], c_im[ci]);
            CMb[((size_t)ldg * CG + c) * 128 + p] = f2bf(c_re[ci]);
            CMb[((size_t)ldg * CG + c) * 128 + 64 + p] = f2bf(-c_im[ci]);
        }
    }
}
__device__ __forceinline__ int s5_chunk_index(int dir, int Rc) {
    if (dir == 0) return Rc;
    return (Rc < CTX / S5C) ? (CTX / S5C - 1 - Rc) : ((T + CTX) / S5C - 1 - Rc);
}
constexpr int S5_HB = 136;
template <int MODE>
__device__ __forceinline__ void phase_s5_scan(int l, const bf16_t* PB, const float2* LAM, const bf16_t* BBb, const bf16_t* CMb,
                                              const float* dvec, float2* SE, const float2* HIN, bf16_t* Zb, float* Zdev,
                                              char* smem, int vb, int nb, int WV) {
    const int TIDX = ltid(WV);
    bf16_t* Ub = (bf16_t*)smem;
    bf16_t* Hb = Ub + 64 * 32;
    float* Ys = (float*)(Hb + 4 * 16 * S5_HB);
    float* BU = Ys + 4 * 64 * 16;
    const int tid = TIDX, wave = tid >> 6, lane = tid & 63, lr = lane & 15, lq = lane >> 4;
    for (int unit = vb; unit < S5NC * 16; unit += nb) {
        const int Rc = unit >> 4, gp = unit & 15;
        const int g = gp * 2 + (wave >> 1), dir = wave & 1;
        const int r0 = Rc * S5C;
        const int ti = ((l * 2 + dir) * G5 + g) * PS + lane;
        __syncthreads();
        {
            const int t = tid >> 2, q = tid & 3;
            *reinterpret_cast<uint4*>(Ub + t * 32 + q * 8) = *reinterpret_cast<const uint4*>(PB + (size_t)(r0 + t) * PBW + PB_S5 + gp * 32 + q * 8);
        }
        bf16x8 cb[4];
        if (MODE == 1) {
            const bf16_t* cm = CMb + ((size_t)((l * 2 + dir) * G5 + g) * CG + lr) * 128 + lq * 8;
#pragma unroll
            for (int ks = 0; ks < 4; ++ks) cb[ks] = *reinterpret_cast<const bf16x8*>(cm + ks * 32);
        }
        const float2 lam = LAM[ti];
        bf16x8 bb[8];
        {
            const bf16_t* bp = BBb + ((size_t)((l * 2 + dir) * G5 + g) * 128 + lr) * 32 + lq * 8;
#pragma unroll
            for (int nt = 0; nt < 8; ++nt) bb[nt] = *reinterpret_cast<const bf16x8*>(bp + nt * 16 * 32);
        }
        const int cidx = s5_chunk_index(dir, Rc);
        float hr = 0.f, hi = 0.f;
        if (MODE == 1) { const float2 h0 = HIN[((size_t)(dir * G5 + g) * S5NC + cidx) * PS + lane]; hr = h0.x; hi = h0.y; }
        __syncthreads();
        bf16_t* hw = Hb + wave * 16 * S5_HB;
        float* buw = BU + wave * 16 * 128;
        for (int tt = 0; tt < S5C; ++tt) {
            if ((tt & 15) == 0) {
                __builtin_amdgcn_wave_barrier();
                const int tts = tt + lr, tla = dir == 0 ? tts : (S5C - 1 - tts);
                union { uint4 u; bf16x8 v; } ua;
                ua.u = make_uint4(0u, 0u, 0u, 0u);
                if (lq < 2) ua.u = *reinterpret_cast<const uint4*>(Ub + tla * 32 + (wave >> 1) * 16 + lq * 8);
#pragma unroll
                for (int nt = 0; nt < 8; ++nt) {
                    f32x4 d = (f32x4){0.f, 0.f, 0.f, 0.f};
                    d = __builtin_amdgcn_mfma_f32_16x16x32_bf16(ua.v, bb[nt], d, 0, 0, 0);
#pragma unroll
                    for (int r = 0; r < 4; ++r) buw[(4 * lq + r) * 128 + 16 * nt + lr] = d[r];
                }
                __builtin_amdgcn_wave_barrier();
            }
            const float bur = buw[(tt & 15) * 128 + lane], bui = buw[(tt & 15) * 128 + 64 + lane];
            float nhr = fmaf(lam.x, hr, fmaf(-lam.y, hi, bur));
            float hr1 = hr, hi1 = hi;
            asm volatile("" : "+v"(nhr), "+v"(hr1), "+v"(hi1));
            float nhi = fmaf(lam.x, hi1, fmaf(lam.y, hr1, bui));
            asm volatile("" : "+v"(nhi));
            hr = nhr; hi = nhi;
            if (MODE == 1) {
                hw[(tt & 15) * S5_HB + lane] = f2bf(hr);
                hw[(tt & 15) * S5_HB + 64 + lane] = f2bf(hi);
                if ((tt & 15) == 15) {
                    __builtin_amdgcn_wave_barrier();
                    f32x4 ya = (f32x4){0.f, 0.f, 0.f, 0.f};
#pragma unroll
                    for (int ks = 0; ks < 4; ++ks) {
                        const bf16x8 ha = *reinterpret_cast<const bf16x8*>(hw + lr * S5_HB + ks * 32 + lq * 8);
                        ya = __builtin_amdgcn_mfma_f32_16x16x32_bf16(ha, cb[ks], ya, 0, 0, 0);
                    }
#pragma unroll
                    for (int r = 0; r < 4; ++r) {
                        const int tts = (tt - 15) + 4 * lq + r;
                        const int tls = dir == 0 ? tts : (S5C - 1 - tts);
                        Ys[wave * 64 * 16 + tls * 16 + lr] = ya[r];
                    }
                    __builtin_amdgcn_wave_barrier();
                }
            }
        }
        if (MODE == 0) {
            SE[((size_t)(dir * G5 + g) * S5NC + cidx) * PS + lane] = make_float2(hr, hi);
        } else {
            __syncthreads();
            for (int e = tid; e < 64 * 32; e += NTHR) {
                const int t = e >> 5, chl = e & 31, gs = chl >> 4, c = chl & 15;
                const int ch = gp * 32 + chl;
                const float y = Ys[(gs * 2 + 0) * 64 * 16 + t * 16 + c] + Ys[(gs * 2 + 1) * 64 * 16 + t * 16 + c] +
                                dvec[ch] * bf2f(Ub[t * 32 + chl]);
                const float z = gelu_f(y);
                Zdev[(size_t)(r0 + t) * DS5 + ch] = z;
            }
        }
    }
}
constexpr int S5_LDS = 64 * 32 * 2 + 4 * 16 * S5_HB * 2 + 4 * 64 * 16 * 4 + 4 * 16 * 128 * 4;

__device__ __forceinline__ void phase_s5_carry(int l, const float2* LAM, const float2* SE, float2* HIN, int vb, int nb, int WV) {
    const int TIDX = ltid(WV);
    for (int i = vb * NTHR + TIDX; i < 2 * G5 * PS; i += nb * NTHR) {
        const int p = i % PS, dg = i / PS;
        float2 lm = LAM[(size_t)(l * 2 * G5 + dg) * PS + p];
#pragma unroll
        for (int s = 1; s < S5C; s <<= 1) {
            float a = fmaf(lm.x, lm.x, -lm.y * lm.y);
            float bx = lm.x, by = lm.y;
            asm volatile("" : "+v"(a), "+v"(bx), "+v"(by));
            const float b = 2.f * bx * by;
            lm = make_float2(a, b);
        }
        float hr = 0.f, hi = 0.f;
        const size_t base = (size_t)dg * S5NC * PS + p;
        for (int c0 = 0; c0 < S5NC; c0 += 12) {
            float2 e[12];
#pragma unroll
            for (int k = 0; k < 12; ++k) e[k] = SE[base + (size_t)(c0 + k) * PS];
#pragma unroll
            for (int k = 0; k < 12; ++k) {
                HIN[base + (size_t)(c0 + k) * PS] = make_float2(hr, hi);
                float nr = fmaf(lm.x, hr, fmaf(-lm.y, hi, e[k].x));
                float hr1 = hr, hi1 = hi;
                asm volatile("" : "+v"(nr), "+v"(hr1), "+v"(hi1));
                float ni = fmaf(lm.x, hi1, fmaf(lm.y, hr1, e[k].y));
                asm volatile("" : "+v"(ni));
                hr = nr; hi = ni;
            }
        }
    }
}
static_assert(S5NC % 12 == 0, "carry unroll");


constexpr int GSC = 192, GNS = T / GSC, GL_QD = 136, GL_KT = 72;
static_assert(GNS * GSC == T && GSC % 64 == 0, "gla superchunk");
constexpr int GLA_LDS = 4096 + 1024 + 512 + 2 * 64 * GL_QD * 2 + 2 * 128 * GL_KT * 2;
constexpr int GLA_UNIT_F = 4 * 64 * 64;
template <int MODE>
__device__ __forceinline__ void phase_gla(const bf16_t* PB, const float* ALPHA, const float* w_alpha, const float* b_alpha,
                                          float* SLOC, float* DEC, const float* SIN, bf16_t* OG, char* smem, int vb, int nb, int WV) {
    const int TIDX = ltid(WV);
    float* As = (float*)smem;
    float* Bt = (float*)(smem + 4096);
    float* EB = (float*)(smem + 5120);
    bf16_t* Qd = (bf16_t*)(smem + 5632);
    bf16_t* Km = Qd + 64 * GL_QD;
    bf16_t* Att = Km;
    bf16_t* KeT = Km + 64 * GL_QD;
    bf16_t* VT = KeT + 128 * GL_KT;
    const int tid = TIDX, wave = tid >> 6, lane = tid & 63, lr = lane & 15, lq = lane >> 4;
    const int k = tid & 127, half = tid >> 7;
    const float qscale = 0.08838834764831845f;
    for (int unit = vb; unit < GNS * 16; unit += nb) {
        const int vh = unit & 1, dir = (unit >> 1) & 1, head = (unit >> 2) & 3, sc = unit >> 4;
        f32x4 S[8][2];
#pragma unroll
        for (int m = 0; m < 8; ++m)
#pragma unroll
            for (int n = 0; n < 2; ++n) {
                if (MODE == 0) S[m][n] = (f32x4){0.f, 0.f, 0.f, 0.f};
                else {
#pragma unroll
                    for (int r = 0; r < 4; ++r)
                        S[m][n][r] = SIN[((size_t)(unit * 4 + wave) * 64 + (m * 2 + n) * 4 + r) * 64 + lane];
                }
            }
        float dsum = 0.f;
        for (int ci = 0; ci < GSC / 64; ++ci) {
            const int j0 = sc * GSC + ci * 64;
            float wcol[RANK];
#pragma unroll
            for (int r = 0; r < RANK; ++r) wcol[r] = w_alpha[(size_t)(dir * RANK + r) * DGK + head * DK + k];
            const float bcol = b_alpha[dir * DGK + head * DK + k];
            __syncthreads();
            for (int e = tid; e < 64 * 16; e += NTHR) {
                const int tt = e >> 4, r = e & 15;
                As[e] = ALPHA[(size_t)scan_row(dir, j0 + tt) * 32 + dir * 16 + r];
            }
            __syncthreads();
            float bl[32];
            {
                float b = 0.f;
#pragma unroll
                for (int i = 0; i < 32; ++i) {
                    const float* ar = As + (half * 32 + i) * 16;
                    float x = bcol;
#pragma unroll
                    for (int r = 0; r < RANK; ++r) x += ar[r] * wcol[r];
                    b += logsigmoid_f(x) * (1.f / 16.f);
                    bl[i] = b;
                }
                Bt[half * 128 + k] = b;
            }
            __syncthreads();
            const float b0 = Bt[k], blast = b0 + Bt[128 + k];
            if (half == 0) { EB[k] = expf(blast); dsum += blast; }
#pragma unroll
            for (int i = 0; i < 32; ++i) {
                if ((i & 7) == 0) asm volatile("" ::: "memory");
                const int tt = half * 32 + i;
                const float bb = bl[i] + (half ? b0 : 0.f);
                const bf16_t* pr = PB + (size_t)scan_row(dir, j0 + tt) * PBW;
                const float kv = bf2f(pr[PB_K + head * DK + k]);
                KeT[k * GL_KT + tt] = f2bf(kv * expf(blast - bb));
                if (MODE == 1) {
                    const float qv = bf2f(pr[PB_Q + head * DK + k]);
                    const float ee = expf(bb);
                    Qd[tt * GL_QD + k] = f2bf(qv * ee * qscale);
                    Km[tt * GL_QD + k] = f2bf(kv / ee);
                }
                VT[k * GL_KT + tt] = pr[PB_V + head * DV + vh * 128 + k];
            }
            __syncthreads();
            bf16x8 vtf[2][2];
#pragma unroll
            for (int ks = 0; ks < 2; ++ks)
#pragma unroll
                for (int n = 0; n < 2; ++n)
                    vtf[ks][n] = *reinterpret_cast<const bf16x8*>(VT + (32 * wave + 16 * n + lr) * GL_KT + ks * 32 + lq * 8);
            if (MODE == 1) {
                f32x4 at[4];
#pragma unroll
                for (int n = 0; n < 4; ++n) at[n] = (f32x4){0.f, 0.f, 0.f, 0.f};
#pragma unroll
                for (int ks = 0; ks < 4; ++ks) {
                    const bf16x8 a = *reinterpret_cast<const bf16x8*>(Qd + (16 * wave + lr) * GL_QD + ks * 32 + lq * 8);
#pragma unroll
                    for (int n = 0; n < 4; ++n) {
                        const bf16x8 bq = *reinterpret_cast<const bf16x8*>(Km + (16 * n + lr) * GL_QD + ks * 32 + lq * 8);
                        at[n] = __builtin_amdgcn_mfma_f32_16x16x32_bf16(a, bq, at[n], 0, 0, 0);
                    }
                }
                __syncthreads();
#pragma unroll
                for (int n = 0; n < 4; ++n)
#pragma unroll
                    for (int r = 0; r < 4; ++r) {
                        const int i = 16 * wave + 4 * lq + r, j = 16 * n + lr;
                        Att[i * GL_KT + j] = f2bf(j <= i ? at[n][r] : 0.f);
                    }
                __syncthreads();
                f32x4 o[4][2];
#pragma unroll
                for (int m = 0; m < 4; ++m)
#pragma unroll
                    for (int n = 0; n < 2; ++n) o[m][n] = (f32x4){0.f, 0.f, 0.f, 0.f};
#pragma unroll
                for (int m = 0; m < 4; ++m)
#pragma unroll
                    for (int ks = 0; ks < 2; ++ks) {
                        const bf16x8 a = *reinterpret_cast<const bf16x8*>(Att + (16 * m + lr) * GL_KT + ks * 32 + lq * 8);
#pragma unroll
                        for (int n = 0; n < 2; ++n) o[m][n] = __builtin_amdgcn_mfma_f32_16x16x32_bf16(a, vtf[ks][n], o[m][n], 0, 0, 0);
                    }
#pragma unroll
                for (int ks = 0; ks < 4; ++ks) {
                    bf16x8 sb[2];
#pragma unroll
                    for (int n = 0; n < 2; ++n) {
#pragma unroll
                        for (int r = 0; r < 4; ++r) {
                            sb[n][r] = (short)f2bf(S[2 * ks][n][r]);
                            sb[n][4 + r] = (short)f2bf(S[2 * ks + 1][n][r]);
                        }
                    }
#pragma unroll
                    for (int m = 0; m < 4; ++m) {
                        const bf16_t* qrow = Qd + (16 * m + lr) * GL_QD + ks * 32 + 4 * lq;
                        const uint2 lo = *reinterpret_cast<const uint2*>(qrow);
                        const uint2 hi = *reinterpret_cast<const uint2*>(qrow + 16);
                        union { uint4 u; bf16x8 v; } cv;
                        cv.u = make_uint4(lo.x, lo.y, hi.x, hi.y);
#pragma unroll
                        for (int n = 0; n < 2; ++n) o[m][n] = __builtin_amdgcn_mfma_f32_16x16x32_bf16(cv.v, sb[n], o[m][n], 0, 0, 0);
                    }
                }
#pragma unroll
                for (int m = 0; m < 4; ++m)
#pragma unroll
                    for (int r = 0; r < 4; ++r) {
                        const int row = scan_row(dir, j0 + 16 * m + 4 * lq + r);
                        bf16_t* og = OG + ((size_t)dir * T + row) * DGV + head * DV + vh * 128 + 32 * wave + lr;
#pragma unroll
                        for (int n = 0; n < 2; ++n) og[16 * n] = f2bf(o[m][n][r]);
                    }
            }
#pragma unroll
            for (int m = 0; m < 8; ++m) {
                const float4 eb = *reinterpret_cast<const float4*>(EB + 16 * m + 4 * lq);
#pragma unroll
                for (int n = 0; n < 2; ++n) { S[m][n][0] *= eb.x; S[m][n][1] *= eb.y; S[m][n][2] *= eb.z; S[m][n][3] *= eb.w; }
            }
#pragma unroll
            for (int ks = 0; ks < 2; ++ks)
#pragma unroll
                for (int m = 0; m < 8; ++m) {
                    const bf16x8 a = *reinterpret_cast<const bf16x8*>(KeT + (16 * m + lr) * GL_KT + ks * 32 + lq * 8);
#pragma unroll
                    for (int n = 0; n < 2; ++n) S[m][n] = __builtin_amdgcn_mfma_f32_16x16x32_bf16(a, vtf[ks][n], S[m][n], 0, 0, 0);
                }
        }
        if (MODE == 0) {
#pragma unroll
            for (int m = 0; m < 8; ++m)
#pragma unroll
                for (int n = 0; n < 2; ++n)
#pragma unroll
                    for (int r = 0; r < 4; ++r)
                        SLOC[((size_t)(unit * 4 + wave) * 64 + (m * 2 + n) * 4 + r) * 64 + lane] = S[m][n][r];
            if (vh == 0 && half == 0) DEC[(size_t)((sc * 4 + head) * 2 + dir) * 128 + k] = expf(dsum);
        }
    }
}

constexpr int GNC = T / 64;
constexpr int GLP_LDS = (64 * 16 + 4 * 64) * 4;
__device__ __forceinline__ void phase_gla_prep(const bf16_t* PB, const float* ALPHA, const float* w_alpha, const float* b_alpha,
                                               bf16_t* QD, bf16_t* KM, bf16_t* KMT, bf16_t* VTg, float* BL, char* smem, int vb,
                                               int nb, int WV) {
    const int TIDX = ltid(WV);
    float* As = (float*)smem;
    float* Bq = As + 64 * 16;
    const int tid = TIDX, kk = tid & 63, tq = tid >> 6;
    const float qscale = 0.08838834764831845f;
    for (int unit = vb; unit < GNC * 16; unit += nb) {
        const int hf = unit & 1, dir = (unit >> 1) & 1, head = (unit >> 2) & 3, ci = unit >> 4;
        const int j0 = ci * 64, k = hf * 64 + kk;
        const size_t dhc = (size_t)(dir * GH + head) * GNC + ci;
        float wcol[RANK];
#pragma unroll
        for (int r = 0; r < RANK; ++r) wcol[r] = w_alpha[(size_t)(dir * RANK + r) * DGK + head * DK + k];
        const float bcol = b_alpha[dir * DGK + head * DK + k];
        __syncthreads();
        for (int e = tid; e < 64 * 16; e += NTHR) {
            const int tt = e >> 4, r = e & 15;
            As[e] = ALPHA[(size_t)scan_row(dir, j0 + tt) * 32 + dir * 16 + r];
        }
        __syncthreads();
        float bl[16];
        {
            float b = 0.f;
#pragma unroll
            for (int i = 0; i < 16; ++i) {
                const float* ar = As + (tq * 16 + i) * 16;
                float x = bcol;
#pragma unroll
                for (int r = 0; r < RANK; ++r) x += ar[r] * wcol[r];
                b += logsigmoid_f(x) * (1.f / 16.f);
                bl[i] = b;
            }
            Bq[tq * 64 + kk] = b;
        }
        __syncthreads();
        float off = 0.f, tot = 0.f;
#pragma unroll
        for (int q = 0; q < 4; ++q) { const float v = Bq[q * 64 + kk]; off += (q < tq) ? v : 0.f; tot += v; }
        if (tq == 0) BL[dhc * 128 + k] = tot;
        unsigned kmt[8];
#pragma unroll
        for (int i = 0; i < 16; ++i) {
            const int tt = tq * 16 + i;
            const float bb = bl[i] + off;
            const bf16_t* pr = PB + (size_t)scan_row(dir, j0 + tt) * PBW;
            const float kv = bf2f(pr[PB_K + head * DK + k]);
            const float qv = bf2f(pr[PB_Q + head * DK + k]);
            const float ee = expf(bb);
            const bf16_t kmb = f2bf(kv / ee);
            QD[(dhc * 64 + tt) * 128 + k] = f2bf(qv * ee * qscale);
            KM[(dhc * 64 + tt) * 128 + k] = kmb;
            if (i & 1) kmt[i >> 1] |= (unsigned)kmb << 16; else kmt[i >> 1] = kmb;
        }
        {
            uint4* dst = reinterpret_cast<uint4*>(KMT + (dhc * 128 + k) * 64 + tq * 16);
            dst[0] = make_uint4(kmt[0], kmt[1], kmt[2], kmt[3]);
            dst[1] = make_uint4(kmt[4], kmt[5], kmt[6], kmt[7]);
        }
        {
            const int vv = tid & 127, th = tid >> 7;
            unsigned vt[16];
#pragma unroll
            for (int i = 0; i < 32; ++i) {
                const bf16_t val = PB[(size_t)scan_row(dir, j0 + th * 32 + i) * PBW + PB_V + head * DV + hf * 128 + vv];
                if (i & 1) vt[i >> 1] |= (unsigned)val << 16; else vt[i >> 1] = val;
            }
            uint4* dst = reinterpret_cast<uint4*>(VTg + (dhc * 256 + hf * 128 + vv) * 64 + th * 32);
#pragma unroll
            for (int q = 0; q < 4; ++q) dst[q] = make_uint4(vt[q * 4], vt[q * 4 + 1], vt[q * 4 + 2], vt[q * 4 + 3]);
        }
    }
}
constexpr int GLA2_LDS = 512 + 2 * 64 * GL_QD * 2 + 2 * 128 * GL_KT * 2;
template <int MODE>
__device__ __forceinline__ void phase_gla2(const bf16_t* QD, const bf16_t* KMg, const bf16_t* KMT, const bf16_t* VTg, const float* BL,
                                           float* SLOC, float* DEC, const float* SIN, bf16_t* OG, char* smem, int vb, int nb, int WV) {
    const int TIDX = ltid(WV);
    float* EB = (float*)smem;
    bf16_t* Qd = (bf16_t*)(smem + 512);
    bf16_t* Km = Qd + 64 * GL_QD;
    bf16_t* Att = Km;
    bf16_t* KeT = Km + 64 * GL_QD;
    bf16_t* VT = KeT + 128 * GL_KT;
    const int tid = TIDX, wave = tid >> 6, lane = tid & 63, lr = lane & 15, lq = lane >> 4;
    for (int unit = vb; unit < GNS * 16; unit += nb) {
        const int vh = unit & 1, dir = (unit >> 1) & 1, head = (unit >> 2) & 3, sc = unit >> 4;
        f32x4 S[8][2];
#pragma unroll
        for (int m = 0; m < 8; ++m)
#pragma unroll
            for (int n = 0; n < 2; ++n) {
                if (MODE == 0) S[m][n] = (f32x4){0.f, 0.f, 0.f, 0.f};
                else {
#pragma unroll
                    for (int r = 0; r < 4; ++r)
                        S[m][n][r] = SIN[((size_t)(unit * 4 + wave) * 64 + (m * 2 + n) * 4 + r) * 64 + lane];
                }
            }
        float dsum = 0.f;
        for (int ci = 0; ci < GSC / 64; ++ci) {
            const int j0 = sc * GSC + ci * 64;
            const size_t dhc = (size_t)(dir * GH + head) * GNC + sc * (GSC / 64) + ci;
            __syncthreads();
            if (tid < 128) { const float blv = BL[dhc * 128 + tid]; EB[tid] = expf(blv); dsum += blv; }
#pragma unroll
            for (int i = 0; i < 4; ++i) {
                const int e = tid + NTHR * i;
                if (MODE == 1) {
                    const int row = e >> 4, c16 = e & 15;
                    *reinterpret_cast<uint4*>(Qd + row * GL_QD + c16 * 8) = *reinterpret_cast<const uint4*>(QD + (dhc * 64 + row) * 128 + c16 * 8);
                    *reinterpret_cast<uint4*>(Km + row * GL_QD + c16 * 8) = *reinterpret_cast<const uint4*>(KMg + (dhc * 64 + row) * 128 + c16 * 8);
                }
                const int row8 = e >> 3, c8 = e & 7;
                *reinterpret_cast<uint4*>(VT + row8 * GL_KT + c8 * 8) =
                    *reinterpret_cast<const uint4*>(VTg + (dhc * 256 + vh * 128 + row8) * 64 + c8 * 8);
                const uint4 kw = *reinterpret_cast<const uint4*>(KMT + (dhc * 128 + row8) * 64 + c8 * 8);
                const float ebk = expf(BL[dhc * 128 + row8]);
                uint4 ko;
                ko.x = pack2bf(bflo(kw.x) * ebk, bfhi(kw.x) * ebk); ko.y = pack2bf(bflo(kw.y) * ebk, bfhi(kw.y) * ebk);
                ko.z = pack2bf(bflo(kw.z) * ebk, bfhi(kw.z) * ebk); ko.w = pack2bf(bflo(kw.w) * ebk, bfhi(kw.w) * ebk);
                *reinterpret_cast<uint4*>(KeT + row8 * GL_KT + c8 * 8) = ko;
            }
            __syncthreads();
            bf16x8 vtf[2][2];
#pragma unroll
            for (int ks = 0; ks < 2; ++ks)
#pragma unroll
                for (int n = 0; n < 2; ++n)
                    vtf[ks][n] = *reinterpret_cast<const bf16x8*>(VT + (32 * wave + 16 * n + lr) * GL_KT + ks * 32 + lq * 8);
            if (MODE == 1) {
                f32x4 at[4];
#pragma unroll
                for (int n = 0; n < 4; ++n) at[n] = (f32x4){0.f, 0.f, 0.f, 0.f};
#pragma unroll
                for (int ks = 0; ks < 4; ++ks) {
                    const bf16x8 a = *reinterpret_cast<const bf16x8*>(Qd + (16 * wave + lr) * GL_QD + ks * 32 + lq * 8);
#pragma unroll
                    for (int n = 0; n < 4; ++n) {
                        const bf16x8 bq = *reinterpret_cast<const bf16x8*>(Km + (16 * n + lr) * GL_QD + ks * 32 + lq * 8);
                        at[n] = __builtin_amdgcn_mfma_f32_16x16x32_bf16(a, bq, at[n], 0, 0, 0);
                    }
                }
                __syncthreads();
#pragma unroll
                for (int n = 0; n < 4; ++n)
#pragma unroll
                    for (int r = 0; r < 4; ++r) {
                        const int i = 16 * wave + 4 * lq + r, j = 16 * n + lr;
                        Att[i * GL_KT + j] = f2bf(j <= i ? at[n][r] : 0.f);
                    }
                __syncthreads();
                f32x4 o[4][2];
#pragma unroll
                for (int m = 0; m < 4; ++m)
#pragma unroll
                    for (int n = 0; n < 2; ++n) o[m][n] = (f32x4){0.f, 0.f, 0.f, 0.f};
#pragma unroll
                for (int m = 0; m < 4; ++m)
#pragma unroll
                    for (int ks = 0; ks < 2; ++ks) {
                        const bf16x8 a = *reinterpret_cast<const bf16x8*>(Att + (16 * m + lr) * GL_KT + ks * 32 + lq * 8);
#pragma unroll
                        for (int n = 0; n < 2; ++n) o[m][n] = __builtin_amdgcn_mfma_f32_16x16x32_bf16(a, vtf[ks][n], o[m][n], 0, 0, 0);
                    }
#pragma unroll
                for (int ks = 0; ks < 4; ++ks) {
                    bf16x8 sb[2];
#pragma unroll
                    for (int n = 0; n < 2; ++n) {
#pragma unroll
                        for (int r = 0; r < 4; ++r) {
                            sb[n][r] = (short)f2bf(S[2 * ks][n][r]);
                            sb[n][4 + r] = (short)f2bf(S[2 * ks + 1][n][r]);
                        }
                    }
#pragma unroll
                    for (int m = 0; m < 4; ++m) {
                        const bf16_t* qrow = Qd + (16 * m + lr) * GL_QD + ks * 32 + 4 * lq;
                        const uint2 lo = *reinterpret_cast<const uint2*>(qrow);
                        const uint2 hi = *reinterpret_cast<const uint2*>(qrow + 16);
                        union { uint4 u; bf16x8 v; } cv;
                        cv.u = make_uint4(lo.x, lo.y, hi.x, hi.y);
#pragma unroll
                        for (int n = 0; n < 2; ++n) o[m][n] = __builtin_amdgcn_mfma_f32_16x16x32_bf16(cv.v, sb[n], o[m][n], 0, 0, 0);
                    }
                }
#pragma unroll
                for (int m = 0; m < 4; ++m)
#pragma unroll
                    for (int r = 0; r < 4; ++r) {
                        const int row = scan_row(dir, j0 + 16 * m + 4 * lq + r);
                        bf16_t* og = OG + ((size_t)dir * T + row) * DGV + head * DV + vh * 128 + 32 * wave + lr;
#pragma unroll
                        for (int n = 0; n < 2; ++n) og[16 * n] = f2bf(o[m][n][r]);
                    }
            }
#pragma unroll
            for (int m = 0; m < 8; ++m) {
                const float4 eb = *reinterpret_cast<const float4*>(EB + 16 * m + 4 * lq);
#pragma unroll
                for (int n = 0; n < 2; ++n) { S[m][n][0] *= eb.x; S[m][n][1] *= eb.y; S[m][n][2] *= eb.z; S[m][n][3] *= eb.w; }
            }
#pragma unroll
            for (int ks = 0; ks < 2; ++ks)
#pragma unroll
                for (int m = 0; m < 8; ++m) {
                    const bf16x8 a = *reinterpret_cast<const bf16x8*>(KeT + (16 * m + lr) * GL_KT + ks * 32 + lq * 8);
#pragma unroll
                    for (int n = 0; n < 2; ++n) S[m][n] = __builtin_amdgcn_mfma_f32_16x16x32_bf16(a, vtf[ks][n], S[m][n], 0, 0, 0);
                }
        }
        if (MODE == 0) {
#pragma unroll
            for (int m = 0; m < 8; ++m)
#pragma unroll
                for (int n = 0; n < 2; ++n)
#pragma unroll
                    for (int r = 0; r < 4; ++r)
                        SLOC[((size_t)(unit * 4 + wave) * 64 + (m * 2 + n) * 4 + r) * 64 + lane] = S[m][n][r];
            if (vh == 0 && tid < 128) DEC[(size_t)((sc * 4 + head) * 2 + dir) * 128 + tid] = expf(dsum);
        }
    }
}
__device__ __forceinline__ void phase_gla_carry(const float* SLOC, const float* DEC, float* SIN, int vb, int nb, int WV) {
    const int TIDX = ltid(WV);
    for (int e = vb * NTHR + TIDX; e < 16 * GLA_UNIT_F; e += nb * NTHR) {
        const int combo = e / GLA_UNIT_F, within = e % GLA_UNIT_F;
        const int head = combo >> 2, dir = (combo >> 1) & 1;
        const int reg = (within >> 6) & 63, lane = within & 63;
        const int kk = 16 * (reg >> 3) + 4 * (lane >> 4) + (reg & 3);
        float s = 0.f;
        for (int s0 = 0; s0 < GNS; s0 += 11) {
            float sl[11], dc[11];
#pragma unroll
            for (int i = 0; i < 11; ++i) {
                sl[i] = SLOC[(size_t)((s0 + i) * 16 + combo) * GLA_UNIT_F + within];
                dc[i] = DEC[(size_t)(((s0 + i) * 4 + head) * 2 + dir) * 128 + kk];
            }
#pragma unroll
            for (int i = 0; i < 11; ++i) {
                SIN[(size_t)((s0 + i) * 16 + combo) * GLA_UNIT_F + within] = s;
                s = dc[i] * s + sl[i];
            }
        }
    }
}
static_assert(GNS % 11 == 0, "gla carry unroll");
__device__ __forceinline__ void phase_gla_finish(const bf16_t* PB, const bf16_t* OG, const float* gn, bf16_t* MIXb, float* MIXdev,
                                                 int vb, int nb, int WV) {
    const int TIDX = ltid(WV);
    const int wave = TIDX >> 6, lane = TIDX & 63;
    for (int u = vb * 4 + wave; u < T * GH; u += nb * 4) {
        const int row = u >> 2, head = u & 3;
        const size_t oi = (size_t)row * DGV + head * DV + lane * 4;
        const uint2 a = *reinterpret_cast<const uint2*>(OG + oi);
        const uint2 b = *reinterpret_cast<const uint2*>(OG + (size_t)T * DGV + oi);
        float o[4] = {bflo(a.x) + bflo(b.x), bfhi(a.x) + bfhi(b.x), bflo(a.y) + bflo(b.y), bfhi(a.y) + bfhi(b.y)};
        float ss = o[0] * o[0] + o[1] * o[1] + o[2] * o[2] + o[3] * o[3];
        ss = wave_sum(ss, lane);
        const float rs = rsqrtf(ss / DV + EPS);
        const uint2 gt = *reinterpret_cast<const uint2*>(PB + (size_t)row * PBW + PB_GATE + head * DV + lane * 4);
        const float gv[4] = {bflo(gt.x), bfhi(gt.x), bflo(gt.y), bfhi(gt.y)};
        float res[4];
#pragma unroll
        for (int i = 0; i < 4; ++i) res[i] = o[i] * rs * gn[lane * 4 + i] * silu_f(gv[i]);
        uint2 pk; pk.x = pack2bf(res[0], res[1]); pk.y = pack2bf(res[2], res[3]);
        *reinterpret_cast<uint2*>(MIXb + (size_t)row * D + DS5 + head * DV + lane * 4) = pk;
        if (MIXdev) {
#pragma unroll
            for (int i = 0; i < 4; ++i) MIXdev[(size_t)row * D + DS5 + head * DV + lane * 4 + i] = res[i];
        }
    }
}


constexpr int HYF_LDS = (64 * 36 + 64 * 64 + 64 * 64) * 4 + 256 * 66 * 2;
__device__ __forceinline__ void phase_hy_filter(const float* w1a, const float* b1a, const float* w2a, const float* b2a,
                                                const float* w3a, const float* fqa, const float* dca, bf16_t* FILT,
                                                bf16_t* FILTC, char* smem, int vb, int nb, int WV) {
    float* zs = (float*)smem;
    float* h1s = zs + 64 * 36;
    float* h2s = h1s + 64 * 64;
    bf16_t* outs = (bf16_t*)(h2s + 64 * 64);
    const int tid = ltid(WV);
    for (int unit = vb; unit < DEPTH * 132; unit += nb) {
        const int l = unit / 132, ti = unit % 132;
        const int isctx = ti >= 128, n = isctx ? CTX : SEQ, t0 = (isctx ? ti - 128 : ti) * 64;
        const float* w1 = w1a + (size_t)l * HYF * HYH; const float* b1 = b1a + (size_t)l * HYH;
        const float* w2 = w2a + (size_t)l * HYH * HYH; const float* b2 = b2a + (size_t)l * HYH;
        const float* w3 = w3a + (size_t)l * HYH * 1024; const float* fq = fqa + (size_t)l * 2 * HYH;
        const float* dc = dca + (size_t)l * 2 * DHY;
        __syncthreads();
        for (int e = tid; e < 64 * HYF; e += NTHR) {
            const int t = e / HYF, f = e % HYF, tg = t0 + t;
            const float tn = (float)tg / (float)(n - 1);
            const float w = 2.0f * 3.14159265358979323846f * (float)tg / (float)n;
            float val;
            if (f == 0) val = tn;
            else {
                const int b = (f - 1) % 16;
                const float band = 1e-4f + (float)b * ((15.0f - 1e-4f) / 15.0f);
                val = (f <= 16) ? cosf(band * w) : -sinf(band * w);
            }
            zs[t * 36 + f] = val;
        }
        __syncthreads();
        {
            const int m = tid & 63, tq = tid >> 6;
            float wc[HYF];
#pragma unroll
            for (int f = 0; f < HYF; ++f) wc[f] = w1[f * HYH + m];
            const float bb = b1[m], ff = fq[m];
            for (int i = 0; i < 16; ++i) {
                const int t = tq * 16 + i;
                float acc = bb;
#pragma unroll
                for (int f = 0; f < HYF; ++f) acc += zs[t * 36 + f] * wc[f];
                h1s[t * 64 + m] = sinf(ff * acc);
            }
        }
        __syncthreads();
        {
            const int m = tid & 63, tq = tid >> 6;
            float wc[HYH];
#pragma unroll
            for (int k = 0; k < HYH; ++k) wc[k] = w2[k * HYH + m];
            const float bb = b2[m], ff = fq[HYH + m];
            for (int i = 0; i < 16; ++i) {
                const int t = tq * 16 + i;
                float acc = bb;
#pragma unroll
                for (int k = 0; k < HYH; ++k) acc += h1s[t * 64 + k] * wc[k];
                h2s[t * 64 + m] = sinf(ff * acc);
            }
        }
        __syncthreads();
        const int wave = tid >> 6, lane = tid & 63, lr = lane & 15, lq = lane >> 4;
        bf16x8 bh[4][2], bl[4][2];
#pragma unroll
        for (int tt = 0; tt < 4; ++tt)
#pragma unroll
            for (int kh = 0; kh < 2; ++kh) {
                const float* hp = h2s + (tt * 16 + lr) * 64 + kh * 32 + lq * 8;
#pragma unroll
                for (int i = 0; i < 8; ++i) {
                    const float x = hp[i];
                    const bf16_t hi = f2bf(x);
                    bh[tt][kh][i] = (short)hi;
                    bl[tt][kh][i] = (short)f2bf(x - bf2f(hi));
                }
            }
        for (int jq = 0; jq < 4; ++jq) {
            for (int jt = 0; jt < 4; ++jt) {
                const int jloc = (wave * 4 + jt) * 16, j0 = jq * 256 + jloc;
                bf16x8 ah[2], al[2];
#pragma unroll
                for (int kh = 0; kh < 2; ++kh)
#pragma unroll
                    for (int i = 0; i < 8; ++i) {
                        const float x = w3[(size_t)(kh * 32 + lq * 8 + i) * 1024 + j0 + lr];
                        const bf16_t hi = f2bf(x);
                        ah[kh][i] = (short)hi;
                        al[kh][i] = (short)f2bf(x - bf2f(hi));
                    }
                float dk[4];
#pragma unroll
                for (int r = 0; r < 4; ++r) dk[r] = fabsf(dc[j0 + lq * 4 + r]);
#pragma unroll
                for (int tt = 0; tt < 4; ++tt) {
                    f32x4 acc = (f32x4){0.f, 0.f, 0.f, 0.f};
#pragma unroll
                    for (int kh = 0; kh < 2; ++kh) {
                        acc = __builtin_amdgcn_mfma_f32_16x16x32_bf16(al[kh], bh[tt][kh], acc, 0, 0, 0);
                        acc = __builtin_amdgcn_mfma_f32_16x16x32_bf16(ah[kh], bl[tt][kh], acc, 0, 0, 0);
                        acc = __builtin_amdgcn_mfma_f32_16x16x32_bf16(ah[kh], bh[tt][kh], acc, 0, 0, 0);
                    }
                    const int t = tt * 16 + lr;
                    const float tn = (float)(t0 + t) / (float)(n - 1);
#pragma unroll
                    for (int r = 0; r < 4; ++r) outs[(jloc + lq * 4 + r) * 66 + t] = f2bf(acc[r] * expf(-tn * dk[r]));
                }
            }
            __syncthreads();
            for (int e = tid; e < 256 * 64; e += NTHR) {
                const int jl = e >> 6, t = e & 63;
                const int jj = jq * 256 + jl, dirn = jj >> 9, c = jj & 511;
                const int lag = t0 + t;
                if (dirn == 1 && lag == 0) continue;
                const bf16_t v = outs[jl * 66 + t];
                if (isctx) FILTC[((size_t)l * DHY + c) * 512 + (dirn ? 256 - lag : 256 + lag)] = v;
                else FILT[((size_t)l * DHY + c) * 16384 + (dirn ? 8192 - lag : 8192 + lag)] = v;
            }
            __syncthreads();
        }
    }
}
constexpr int HYS_LDS = 64 * 72 * 2;
__device__ __forceinline__ void phase_hy_short(const bf16_t* PB, const float* cw, const float* cb, bf16_t* X0b, bf16_t* ST,
                                               char* smem, int vb, int nb, int WV) {
    const int TIDX = ltid(WV);
    bf16_t* ts = (bf16_t*)smem;
    const int tid = TIDX, ck = tid & 7, pl = tid >> 3;
    for (int unit = vb; unit < (T / 64) * 8; unit += nb) {
        const int rt = unit >> 3, cg = unit & 7, r0 = rt * 64;
        const int base = r0 < CTX ? 0 : CTX, n = r0 < CTX ? CTX : SEQ;
        const int c0 = cg * 64 + ck * 8;
        __syncthreads();
#pragma unroll
        for (int h = 0; h < 2; ++h) {
            const int pos = pl + 32 * h, row = r0 + pos, li = row - base;
            float z[3][8];
#pragma unroll
            for (int part = 0; part < 3; ++part) {
                const int cc = part * 512 + c0;
                const float4 b0 = *reinterpret_cast<const float4*>(cb + cc), b1 = *reinterpret_cast<const float4*>(cb + cc + 4);
                float acc[8] = {b0.x, b0.y, b0.z, b0.w, b1.x, b1.y, b1.z, b1.w};
#pragma unroll
                for (int j = 0; j < 3; ++j) {
                    const int sp = li + j - 1;
                    if (sp >= 0 && sp < n) {
                        const uint4 v = *reinterpret_cast<const uint4*>(PB + (size_t)(base + sp) * PBW + PB_HY + cc);
                        const float4 w0 = *reinterpret_cast<const float4*>(cw + j * 1536 + cc);
                        const float4 w1 = *reinterpret_cast<const float4*>(cw + j * 1536 + cc + 4);
                        acc[0] += w0.x * bflo(v.x); acc[1] += w0.y * bfhi(v.x); acc[2] += w0.z * bflo(v.y); acc[3] += w0.w * bfhi(v.y);
                        acc[4] += w1.x * bflo(v.z); acc[5] += w1.y * bfhi(v.z); acc[6] += w1.z * bflo(v.w); acc[7] += w1.w * bfhi(v.w);
                    }
                }
#pragma unroll
                for (int i = 0; i < 8; ++i) z[part][i] = acc[i];
            }
            uint4 o;
            o.x = pack2bf(z[0][0], z[0][1]); o.y = pack2bf(z[0][2], z[0][3]); o.z = pack2bf(z[0][4], z[0][5]); o.w = pack2bf(z[0][6], z[0][7]);
            *reinterpret_cast<uint4*>(X0b + (size_t)row * DHY + c0) = o;
#pragma unroll
            for (int i = 0; i < 8; ++i) ts[(ck * 8 + i) * 72 + pos] = f2bf(z[1][i] * z[2][i]);
        }
        __syncthreads();
        for (int e = tid; e < 64 * 8; e += NTHR) {
            const int ch = e >> 3, p8 = (e & 7) * 8;
            *reinterpret_cast<uint4*>(ST + (size_t)(cg * 64 + ch) * T + r0 + p8) = *reinterpret_cast<const uint4*>(ts + ch * 72 + p8);
        }
    }
}
struct __attribute__((packed, aligned(4))) HyTapQ { unsigned x, y; };
__device__ __forceinline__ bf16x8 hy_tap_frag(const bf16_t* p4, unsigned sh) {
    const HyTapQ q0 = *reinterpret_cast<const HyTapQ*>(p4), q1 = *reinterpret_cast<const HyTapQ*>(p4 + 4);
    const unsigned q2 = *reinterpret_cast<const unsigned*>(p4 + 8);
    union { uint4 u; bf16x8 v; } cv;
    cv.u = make_uint4(__builtin_amdgcn_alignbit(q0.y, q0.x, sh), __builtin_amdgcn_alignbit(q1.x, q0.y, sh), __builtin_amdgcn_alignbit(q1.y, q1.x, sh),
                      __builtin_amdgcn_alignbit(q2, q1.y, sh));
    return cv.v;
}
__device__ __forceinline__ unsigned rot16(unsigned v) { return __builtin_amdgcn_alignbit(v, v, 16); }
constexpr int HYC_LDS = 32768 + 16384;
__device__ __forceinline__ void phase_hy_conv(int l, const bf16_t* FILT, const bf16_t* FILTC, const bf16_t* ST, bf16_t* YT,
                                              char* smem, int vb, int nb, int WV) {
    const int TIDX = ltid(WV);
    bf16_t* fl = (bf16_t*)smem;
    bf16_t* xs = (bf16_t*)(smem + 32768);
    bf16_t* ys = fl;
    const int tid = TIDX, wave = tid >> 6, lane = tid & 63, lr = lane & 15, lq = lane >> 4;
    for (int unit = vb; unit < 2 * DHY; unit += nb) {
        const int seq = unit >> 9, c = unit & 511;
        const int n = seq ? CTX : SEQ, NB = n / 64, off = seq ? 0 : CTX;
        const bf16_t* F = seq ? FILTC + ((size_t)l * DHY + c) * 512 : FILT + ((size_t)l * DHY + c) * 16384;
        __syncthreads();
        for (int e = tid; e < 2 * n / 8; e += NTHR) {
            const uint4 v = reinterpret_cast<const uint4*>(F)[e];
            reinterpret_cast<uint4*>(fl)[2 * n / 8 - 1 - e] = make_uint4(rot16(v.w), rot16(v.z), rot16(v.y), rot16(v.x));
        }
        for (int e = tid; e < n / 8; e += NTHR)
            reinterpret_cast<uint4*>(xs)[e] = *reinterpret_cast<const uint4*>(ST + (size_t)c * T + off + e * 8);
        f32x4 acc[8];
#pragma unroll
        for (int i = 0; i < 8; ++i) acc[i] = (f32x4){0.f, 0.f, 0.f, 0.f};
        __syncthreads();
        const int rho = 3 - (lr & 3);
        const unsigned tsh = (rho & 1) * 16;
        const bf16_t* ga0 = fl + (n - 1) - 16 * wave - lr + 8 * lq - (rho & 1);
        if (!seq) {
            for (int r = 0; r < 16; ++r) {
                bf16x8 bq[9][2];
#pragma unroll
                for (int m = 0; m < 9; ++m) {
                    const int J = 16 * m + lr - r;
                    const bool valid = (J >= 0) && (J < 128);
                    const uint4* px = reinterpret_cast<const uint4*>(xs + 64 * (valid ? J : 0) + 8 * lq);
#pragma unroll
                    for (int ks = 0; ks < 2; ++ks) {
                        uint4 bv = px[4 * ks];
                        if ((m == 0 || m == 8) && !valid) bv = make_uint4(0u, 0u, 0u, 0u);
                        union { uint4 u; bf16x8 v; } cv;
                        cv.u = bv;
                        bq[m][ks] = cv.v;
                    }
                }
                const bf16_t* ga = ga0 - 64 * r - 1024 * 7;
#pragma unroll
                for (int si = 15; si >= 0; --si) {
                    const int sg = si - 8;
                    const bf16x8 a0 = hy_tap_frag(ga + 1024 * (7 - sg), tsh), a1 = hy_tap_frag(ga + 1024 * (7 - sg) + 32, tsh);
#pragma unroll
                    for (int m = 0; m < 9; ++m)
                        if (m + sg >= 0 && m + sg < 8) acc[m + sg] = __builtin_amdgcn_mfma_f32_16x16x32_bf16(a0, bq[m][0], acc[m + sg], 0, 0, 0);
#pragma unroll
                    for (int m = 0; m < 9; ++m)
                        if (m + sg >= 0 && m + sg < 8) acc[m + sg] = __builtin_amdgcn_mfma_f32_16x16x32_bf16(a1, bq[m][1], acc[m + sg], 0, 0, 0);
                }
            }
        } else {
            for (int dl = -(NB - 1); dl <= NB - 1; ++dl) {
                const int J = lr - dl;
                const bool valid = (J >= 0) && (J < NB);
                const int Jc = valid ? J : 0;
#pragma unroll
                for (int ks = 0; ks < 2; ++ks) {
                    const bf16x8 a = hy_tap_frag(ga0 - 64 * dl + 32 * ks, tsh);
                    uint4 bv = *reinterpret_cast<const uint4*>(xs + 64 * Jc + 32 * ks + 8 * lq);
                    if (!valid) bv = make_uint4(0u, 0u, 0u, 0u);
                    union { uint4 u; bf16x8 v; } cv;
                    cv.u = bv;
                    acc[0] = __builtin_amdgcn_mfma_f32_16x16x32_bf16(a, cv.v, acc[0], 0, 0, 0);
                }
            }
        }
        __syncthreads();
#pragma unroll
        for (int nt = 0; nt < 8; ++nt) {
            const int I = 16 * nt + lr;
            if (I < NB) {
                uint2 pk;
                pk.x = pack2bf(acc[nt][0], acc[nt][1]);
                pk.y = pack2bf(acc[nt][2], acc[nt][3]);
                *reinterpret_cast<uint2*>(ys + 64 * I + 16 * wave + 4 * lq) = pk;
            }
        }
        __syncthreads();
        for (int e = tid; e < n / 8; e += NTHR)
            *reinterpret_cast<uint4*>(YT + (size_t)c * T + off + e * 8) = reinterpret_cast<const uint4*>(ys)[e];
    }
}
constexpr int HYN_LDS = 2 * 64 * 72 * 2;
__device__ __forceinline__ void phase_hy_finish(const bf16_t* X0b, const bf16_t* ST, const bf16_t* YT, const float* bias,
                                                bf16_t* MIXb, float* MIXdev, char* smem, int vb, int nb, int WV) {
    const int TIDX = ltid(WV);
    bf16_t* ss = (bf16_t*)smem;
    bf16_t* yy = ss + 64 * 72;
    const int tid = TIDX;
    for (int unit = vb; unit < (T / 64) * 8; unit += nb) {
        const int rt = unit >> 3, cg = unit & 7, r0 = rt * 64;
        __syncthreads();
        for (int e = tid; e < 64 * 8; e += NTHR) {
            const int ch = e >> 3, p8 = (e & 7) * 8;
            *reinterpret_cast<uint4*>(ss + ch * 72 + p8) = *reinterpret_cast<const uint4*>(ST + (size_t)(cg * 64 + ch) * T + r0 + p8);
            *reinterpret_cast<uint4*>(yy + ch * 72 + p8) = *reinterpret_cast<const uint4*>(YT + (size_t)(cg * 64 + ch) * T + r0 + p8);
        }
        __syncthreads();
        for (int e = tid; e < 64 * 8; e += NTHR) {
            const int pos = e >> 3, ch0 = (e & 7) * 8, c0 = cg * 64 + ch0, row = r0 + pos;
            const uint4 xv = *reinterpret_cast<const uint4*>(X0b + (size_t)row * DHY + c0);
            const float4 b0 = *reinterpret_cast<const float4*>(bias + c0), b1 = *reinterpret_cast<const float4*>(bias + c0 + 4);
            const float xf[8] = {bflo(xv.x), bfhi(xv.x), bflo(xv.y), bfhi(xv.y), bflo(xv.z), bfhi(xv.z), bflo(xv.w), bfhi(xv.w)};
            const float bb[8] = {b0.x, b0.y, b0.z, b0.w, b1.x, b1.y, b1.z, b1.w};
            float o[8];
#pragma unroll
            for (int i = 0; i < 8; ++i) o[i] = xf[i] * (bf2f(yy[(ch0 + i) * 72 + pos]) + bb[i] * bf2f(ss[(ch0 + i) * 72 + pos]));
            uint4 ov;
            ov.x = pack2bf(o[0], o[1]); ov.y = pack2bf(o[2], o[3]); ov.z = pack2bf(o[4], o[5]); ov.w = pack2bf(o[6], o[7]);
            *reinterpret_cast<uint4*>(MIXb + (size_t)row * D + 1536 + c0) = ov;
        }
    }
}


struct EpiBf16 {
    bf16_t* C; int ldc;
    __device__ __forceinline__ void operator()(int m, int n, const f32x4& a) const {
#pragma unroll
        for (int r = 0; r < 4; ++r) C[(size_t)(m + r) * ldc + n] = f2bf(a[r]);
    }
};
__device__ __forceinline__ unsigned f_enc(float f) {
    const unsigned u = __float_as_uint(f);
    return (u & 0x80000000u) ? ~u : (u | 0x80000000u);
}
__device__ __forceinline__ float f_dec(unsigned e) {
    return __uint_as_float((e & 0x80000000u) ? (e & 0x7fffffffu) : ~e);
}
__device__ __forceinline__ void ins16(unsigned (&t)[16], unsigned c) {
#pragma unroll
    for (int j = 0; j < 16; ++j) { const unsigned hi = max(t[j], c); c = min(t[j], c); t[j] = hi; }
}
__device__ __forceinline__ void bitonic16_desc(unsigned (&m)[16]) {
#pragma unroll
    for (int d = 8; d > 0; d >>= 1)
#pragma unroll
        for (int i = 0; i < 16; ++i)
            if ((i & d) == 0) { const unsigned hi = max(m[i], m[i + d]), lo = min(m[i], m[i + d]); m[i] = hi; m[i + d] = lo; }
}
__device__ __forceinline__ void sort16_desc(unsigned (&m)[16]) {
#pragma unroll
    for (int k = 2; k <= 16; k <<= 1)
#pragma unroll
        for (int j = k >> 1; j > 0; j >>= 1)
#pragma unroll
            for (int i = 0; i < 16; ++i) {
                const int p = i ^ j;
                if (p > i) {
                    const bool desc = (i & k) == 0 || k == 16;
                    const unsigned hi = max(m[i], m[p]), lo = min(m[i], m[p]);
                    m[i] = desc ? hi : lo; m[p] = desc ? lo : hi;
                }
            }
}
__device__ __forceinline__ void merge16_desc(unsigned (&x)[16], const unsigned (&y)[16]) {
#pragma unroll
    for (int j = 0; j < 16; ++j) x[j] = max(x[j], y[15 - j]);
    bitonic16_desc(x);
}
constexpr int PSEL_STRIDE = 131, PSEL_LDS = 128 * PSEL_STRIDE * 4;
__device__ __forceinline__ void phase_peer_select(const bf16_t* Qb, const bf16_t* KEYSb  , int* IDX,
                                                  float* GATE, char* smem, int vb, int nb, int WV) {
    const int TIDX = ltid(WV);
    float* sc = (float*)smem;
    unsigned* LA = (unsigned*)smem;
    unsigned* M1 = (unsigned*)(smem + 8192);
    unsigned* LB = (unsigned*)(smem + 16384);
    const int tid = TIDX, wave = tid >> 6, lane = tid & 63, lr = lane & 15, lq = lane >> 4;
    for (int unit = vb; unit < (T / 64) * PH; unit += nb) {
        const int tt = unit >> 3, h = unit & 7, tok0 = tt * 64;
        __syncthreads();
#pragma unroll
        for (int s = 0; s < 2; ++s) {
            bf16x8 af[4];
#pragma unroll
            for (int ks = 0; ks < 4; ++ks)
                af[ks] = *reinterpret_cast<const bf16x8*>(Qb + (size_t)(tok0 + 16 * wave + lr) * D + h * PDQ + s * 128 + ks * 32 + lq * 8);
            const bf16_t* kb = KEYSb + (size_t)(h * 2 + s) * PKEYS * 128;
#pragma unroll
            for (int nt = 0; nt < 8; ++nt) {
                f32x4 acc = (f32x4){0.f, 0.f, 0.f, 0.f};
#pragma unroll
                for (int ks = 0; ks < 4; ++ks) {
                    const bf16x8 bq = *reinterpret_cast<const bf16x8*>(kb + (size_t)(16 * nt + lr) * 128 + ks * 32 + lq * 8);
                    acc = __builtin_amdgcn_mfma_f32_16x16x32_bf16(af[ks], bq, acc, 0, 0, 0);
                }
#pragma unroll
                for (int r = 0; r < 4; ++r) sc[((16 * wave + 4 * lq + r) * 2 + s) * PSEL_STRIDE + 16 * nt + lr] = acc[r];
            }
        }
        __syncthreads();
        unsigned t16[16];
        {
            const int list = tid & 127, half = tid >> 7;
            const float* sp = sc + list * PSEL_STRIDE + 64 * half;
#pragma unroll
            for (int g = 0; g < 4; ++g) {
                unsigned q16[16];
#pragma unroll
                for (int i = 0; i < 16; ++i) q16[i] = (f_enc(sp[16 * g + i]) & ~0x7fu) | (unsigned)(127 - (64 * half + 16 * g + i));
                sort16_desc(q16);
                if (g == 0) {
#pragma unroll
                    for (int i = 0; i < 16; ++i) t16[i] = q16[i];
                } else merge16_desc(t16, q16);
            }
            __syncthreads();
            if (half == 1) {
#pragma unroll
                for (int j = 0; j < 16; ++j) LA[list * 16 + j] = t16[j];
            }
            __syncthreads();
            if (half == 0) {
#pragma unroll
                for (int j = 0; j < 16; ++j) t16[j] = max(t16[j], LA[list * 16 + 15 - j]);
                bitonic16_desc(t16);
#pragma unroll
                for (int j = 0; j < 16; ++j) M1[list * 16 + j] = t16[j];
            }
            __syncthreads();
        }
        {
            const int tok = tid >> 2, aq = tid & 3;
            float v1[4], v2[16];
#pragma unroll
            for (int a = 0; a < 4; ++a) v1[a] = f_dec(M1[(tok * 2 + 0) * 16 + 4 * aq + a] & ~0x7fu);
#pragma unroll
            for (int b = 0; b < 16; ++b) v2[b] = f_dec(M1[(tok * 2 + 1) * 16 + b] & ~0x7fu);
            unsigned c16[16];
#pragma unroll
            for (int a = 0; a < 4; ++a) {
                unsigned r16[16];
#pragma unroll
                for (int b = 0; b < 16; ++b) r16[b] = (f_enc(v1[a] + v2[b]) & ~0xffu) | (unsigned)(255 - ((4 * aq + a) * 16 + b));
                if (a == 0) {
#pragma unroll
                    for (int b = 0; b < 16; ++b) c16[b] = r16[b];
                } else merge16_desc(c16, r16);
            }
#pragma unroll
            for (int round = 0; round < 2; ++round) {
                const int stride = 1 << round;
                const bool sender = (aq & (2 * stride - 1)) == stride;
                const bool recver = (aq & (2 * stride - 1)) == 0;
                if (sender) {
#pragma unroll
                    for (int j = 0; j < 16; ++j) LB[(tok * 4 + aq) * 16 + j] = c16[j];
                }
                __syncthreads();
                if (recver) {
#pragma unroll
                    for (int j = 0; j < 16; ++j) c16[j] = max(c16[j], LB[(tok * 4 + aq + stride) * 16 + 15 - j]);
                    bitonic16_desc(c16);
                }
                __syncthreads();
            }
            if (aq == 0) {
                float sv[16]; int ex[16];
#pragma unroll
                for (int j = 0; j < 16; ++j) {
                    const unsigned flat = 255u - (c16[j] & 0xffu);
                    sv[j] = f_dec(c16[j] & ~0xffu);
                    const unsigned k1 = M1[(tok * 2 + 0) * 16 + (flat >> 4)], k2 = M1[(tok * 2 + 1) * 16 + (flat & 15u)];
                    ex[j] = (int)((127u - (k1 & 0x7fu)) * PKEYS + (127u - (k2 & 0x7fu)));
                }
                float sum = 0.f, ev[16];
#pragma unroll
                for (int j = 0; j < 16; ++j) { ev[j] = expf(sv[j] - sv[0]); sum += ev[j]; }
                const float inv = 1.f / sum;
                int* ip = IDX + (size_t)(tok0 + tok) * 128 + h * 16;
                float* gp = GATE + (size_t)(tok0 + tok) * 128 + h * 16;
#pragma unroll
                for (int j = 0; j < 16; ++j) { ip[j] = ex[j]; gp[j] = ev[j] * inv; }
            }
        }
    }
}

#define XB_TMO      128
#define XB_XCNT(j)  (256  + 64 * (j))
#define XB_XSUB(j)  (1280 + 64 * (j))
#define XB_XGEN(j)  (2304 + 64 * (j))
#define XB_TOP      3328
#define XB_TOPGEN   3392
#define XCD_BAR_WORDS 3456
#define XB_SPIN_CAP (1u << 18)
#define LAS __attribute__((address_space(3)))

__device__ __forceinline__ unsigned xb_ld(unsigned* p)              { return __hip_atomic_load(p, __ATOMIC_RELAXED, __HIP_MEMORY_SCOPE_AGENT); }
__device__ __forceinline__ unsigned xb_add(unsigned* p, unsigned v) { return __hip_atomic_fetch_add(p, v, __ATOMIC_RELAXED, __HIP_MEMORY_SCOPE_AGENT); }
__device__ __forceinline__ unsigned xb_xcc_id() { return (unsigned)__builtin_amdgcn_s_getreg((3 << 11) | 20) & 0xFu; }
#define XB_SPIN(cond, bar) do { unsigned _sp = 0; while (cond) { __builtin_amdgcn_s_sleep(1); \
    if ((++_sp & 255u) == 0u) { if (xb_ld(&(bar)[XB_TMO])) break; if (_sp > XB_SPIN_CAP) { atomicAdd(&(bar)[XB_TMO], 1u); break; } } } } while (0)

struct XcdBarrier {
    unsigned* bar; unsigned x;
    volatile LAS unsigned* st;
};

__device__ __forceinline__ XcdBarrier xcd_barrier_post(unsigned* bar, volatile LAS unsigned* st) {
    XcdBarrier b; b.bar = bar; b.x = xb_xcc_id(); b.st = st;
    if (threadIdx.x == 0) (void)xb_add(&bar[XB_XCNT(b.x)], 1u);
    return b;
}
__device__ __forceinline__ void xcd_barrier_complete(unsigned* bar, unsigned x, unsigned& nloc, unsigned& nx) {
    const unsigned G = gridDim.x * gridDim.y * gridDim.z;
    unsigned sum, cnt, mine, sp = 0u;
    for (;;) {
        sum = 0u; cnt = 0u; mine = 0u;
#pragma unroll
        for (unsigned j = 0; j < 16; ++j) { const unsigned c = xb_ld(&bar[XB_XCNT(j)]); sum += c; cnt += (c > 0u) ? 1u : 0u; mine = (j == x) ? c : mine; }
        if (sum == G) break;
        __builtin_amdgcn_s_sleep(1);
        if ((++sp & 255u) == 0u) { if (xb_ld(&bar[XB_TMO])) break; if (sp > XB_SPIN_CAP) { atomicAdd(&bar[XB_TMO], 1u); break; } }
    }
    nloc = mine > 0u ? mine : 1u; nx = cnt > 0u ? cnt : 1u;
}

__device__ __forceinline__ void xcd_barrier(const XcdBarrier& b) {
    asm volatile("s_waitcnt vmcnt(0)" ::: "memory");
    __syncthreads();
    if (threadIdx.x == 0) {
        unsigned* bar = b.bar;
        __builtin_amdgcn_s_waitcnt(0);
        unsigned nloc = b.st[0], nx = b.st[1];
        if (nloc == 0u) { xcd_barrier_complete(bar, b.x, nloc, nx); b.st[0] = nloc; b.st[1] = nx; }
        const unsigned old = xb_add(&bar[XB_XSUB(b.x)], 1u);
        const unsigned gen = old / nloc;
        if (old + 1u == (gen + 1u) * nloc) {
            __builtin_amdgcn_fence(__ATOMIC_RELEASE, "agent");
            asm volatile("s_waitcnt vmcnt(0)" ::: "memory");
            const unsigned og = xb_add(&bar[XB_TOP], 1u);
            const unsigned tg = og / nx;
            if (og + 1u == (tg + 1u) * nx) xb_add(&bar[XB_TOPGEN], 1u);
            else XB_SPIN(xb_ld(&bar[XB_TOPGEN]) == tg, bar);
            __builtin_amdgcn_fence(__ATOMIC_ACQUIRE, "agent");
            xb_add(&bar[XB_XGEN(b.x)], 1u);
            asm volatile("s_waitcnt vmcnt(0)" ::: "memory");
        } else {
            XB_SPIN(xb_ld(&bar[XB_XGEN(b.x)]) == gen, bar);
            __builtin_amdgcn_fence(__ATOMIC_ACQUIRE, "agent");
            asm volatile("s_waitcnt vmcnt(0)" ::: "memory");
        }
    }
    __syncthreads();
}


__device__ __forceinline__ void grid_sync(const XcdBarrier& b0) {
    XcdBarrier b = b0;
    asm volatile("" : "+s"(b.bar), "+s"(b.x));
    xcd_barrier(b);
}

__device__ __forceinline__ void phase_init_h(const float* x, const float* ctx, float* H, int vb, int nb, int WV) {
    const int TIDX = ltid(WV);
    const int wave = TIDX >> 6, lane = TIDX & 63;
    float om[2][4];
#pragma unroll
    for (int b = 0; b < 2; ++b)
#pragma unroll
        for (int e = 0; e < 4; ++e) om[b][e] = 1.0f / powf(10000.0f, (float)(b * 256 + lane * 4 + e) / 512.0f);
    float pc[4][4];
    int cprev = -1;
    for (int row = vb * 4 + wave; row < T; row += nb * 4) {
        if (row < CTX) {
#pragma unroll
            for (int i = 0; i < 8; ++i) {
                const int d = i * 256 + lane * 4;
                *reinterpret_cast<float4*>(H + (size_t)row * D + d) = *reinterpret_cast<const float4*>(ctx + (size_t)row * D + d);
            }
            continue;
        }
        const int t = row - CTX, r = t / 64, c = t % 64;
        float4 v[8];
#pragma unroll
        for (int i = 0; i < 8; ++i) v[i] = *reinterpret_cast<const float4*>(x + (size_t)t * D + i * 256 + lane * 4);
        if (c != cprev) {
            cprev = c;
#pragma unroll
            for (int b = 0; b < 2; ++b)
#pragma unroll
                for (int e = 0; e < 4; ++e) {
                    const float a = (float)c * om[b][e];
                    pc[b][e] = sinf(a);
                    pc[2 + b][e] = cosf(a);
                }
        }
#pragma unroll
        for (int b = 0; b < 2; ++b) {
            float sr[4], cr[4];
#pragma unroll
            for (int e = 0; e < 4; ++e) {
                const float a = (float)r * om[b][e];
                sr[e] = sinf(a);
                cr[e] = cosf(a);
            }
            v[b].x += sr[0]; v[b].y += sr[1]; v[b].z += sr[2]; v[b].w += sr[3];
            v[2 + b].x += cr[0]; v[2 + b].y += cr[1]; v[2 + b].z += cr[2]; v[2 + b].w += cr[3];
            v[4 + b].x += pc[b][0]; v[4 + b].y += pc[b][1]; v[4 + b].z += pc[b][2]; v[4 + b].w += pc[b][3];
            v[6 + b].x += pc[2 + b][0]; v[6 + b].y += pc[2 + b][1]; v[6 + b].z += pc[2 + b][2]; v[6 + b].w += pc[2 + b][3];
        }
#pragma unroll
        for (int i = 0; i < 8; ++i) *reinterpret_cast<float4*>(H + (size_t)row * D + i * 256 + lane * 4) = v[i];
    }
}
constexpr int ADA_LDS = (2 * D + 4 * 128 * 2) * 4;
__device__ __forceinline__ void phase_ada(const float* c, const float* cctx, const float* w_ada, const float* b_ada, float* MOD,
                                          char* smem, int vb, int nb, int WV) {
    const int TIDX = ltid(WV);
    float* s0 = (float*)smem;
    float* s1 = s0 + D;
    float* red = s1 + D;
    const int tid = TIDX, wave = tid >> 6, lane = tid & 63;
    if (vb >= DEPTH * 96) return;
    __syncthreads();
    for (int i = tid; i < D; i += NTHR) { s0[i] = silu_f(c[i]); s1[i] = silu_f(cctx[i]); }
    __syncthreads();
    for (int unit = vb; unit < DEPTH * 96; unit += nb) {
        const int l = unit / 96, cb = unit % 96;
        const float* w = w_ada + ((size_t)l * D + wave * 512) * 6 * D + cb * 128 + lane * 2;
        float a0x = 0.f, a0y = 0.f, a1x = 0.f, a1y = 0.f;
        for (int i0 = 0; i0 < 512; i0 += 8) {
            float2 wv[8];
#pragma unroll
            for (int k = 0; k < 8; ++k) {
                const f32x2_t t2 = __builtin_nontemporal_load(reinterpret_cast<const f32x2_t*>(w + (size_t)(i0 + k) * 6 * D));
                wv[k] = make_float2(t2[0], t2[1]);
            }
#pragma unroll
            for (int k = 0; k < 8; ++k) {
                const float f0 = s0[wave * 512 + i0 + k], f1 = s1[wave * 512 + i0 + k];
                a0x += f0 * wv[k].x; a0y += f0 * wv[k].y; a1x += f1 * wv[k].x; a1y += f1 * wv[k].y;
            }
        }
        __syncthreads();
        red[(wave * 128 + lane * 2 + 0) * 2 + 0] = a0x; red[(wave * 128 + lane * 2 + 1) * 2 + 0] = a0y;
        red[(wave * 128 + lane * 2 + 0) * 2 + 1] = a1x; red[(wave * 128 + lane * 2 + 1) * 2 + 1] = a1y;
        __syncthreads();
        {
            const int col = tid & 127, cls = tid >> 7;
            float s = b_ada[(size_t)l * 6 * D + cb * 128 + col];
#pragma unroll
            for (int w4 = 0; w4 < 4; ++w4) s += red[(w4 * 128 + col) * 2 + cls];
            MOD[((size_t)l * 2 + cls) * 6 * D + cb * 128 + col] = s;
        }
    }
}
__device__ __forceinline__ void phase_final(const float* H, const float* g, float* out, int vb, int nb, int WV) {
    const int TIDX = ltid(WV);
    const int wave = TIDX >> 6, lane = TIDX & 63;
    for (int t = vb * 4 + wave; t < SEQ; t += nb * 4) {
        const float* h = H + (size_t)(CTX + t) * D;
        float4 v[8];
        float ss = 0.f;
#pragma unroll
        for (int i = 0; i < 8; ++i) {
            v[i] = *reinterpret_cast<const float4*>(h + i * 256 + lane * 4);
            ss += v[i].x * v[i].x + v[i].y * v[i].y + v[i].z * v[i].z + v[i].w * v[i].w;
        }
        ss = wave_sum(ss, lane);
        const float rs = rsqrtf(ss / D + EPS);
#pragma unroll
        for (int i = 0; i < 8; ++i) {
            const int d = i * 256 + lane * 4;
            const float4 gg = *reinterpret_cast<const float4*>(g + d);
            float4 o;
            o.x = v[i].x * rs * gg.x; o.y = v[i].y * rs * gg.y; o.z = v[i].z * rs * gg.z; o.w = v[i].w * rs * gg.w;
            *reinterpret_cast<float4*>(out + (size_t)t * D + d) = o;
        }
    }
}

struct Params {
    const float *x, *c, *ctx, *c_ctx, *w_ada, *b_ada, *g_norm1, *g_norm2, *w_in, *s5_a_re, *s5_a_im, *s5_log_step, *s5_b_re,
        *s5_b_im, *s5_c_re, *s5_c_im, *s5_d, *s5_w_glu, *s5_b_glu, *gla_w_alpha, *gla_b_alpha, *gla_g_norm, *hy_conv_w,
        *hy_conv_b, *hy_f_w1, *hy_f_b1, *hy_f_w2, *hy_f_b2, *hy_f_w3, *hy_f_freq, *hy_decay, *hy_bias, *w_out, *peer_w_q,
        *peer_keys, *peer_u, *peer_v, *g_final;
    float* out;
    unsigned* bar;
    float *H, *MOD, *ALPHA, *SLOC, *SIN, *DEC, *GATE;
    float2 *LAM, *BBAR, *CSt, *SE, *HIN;
    bf16_t *CMb, *BBb, *GQD, *GKM, *GKMT, *GVT;
    float* GBL;
    int* IDX;
    bf16_t *WinT, *WoutT, *WqT, *WgluT, *KEYSb, *FILT, *FILTC, *A1b, *PB, *MIXb, *OGb, *X0b, *STb, *YTb, *Qb;
    float* Zf;
    unsigned char *U8, *V8;
};
constexpr int INP = 5248;
constexpr int LDS_MAX = 76032;
static_assert(GLA2_LDS <= LDS_MAX && GLP_LDS <= LDS_MAX && GEMM_LDS <= LDS_MAX && S5_LDS <= LDS_MAX && HYF_LDS <= LDS_MAX && HYC_LDS <= LDS_MAX && PSEL_LDS <= LDS_MAX &&
              ADA_LDS <= LDS_MAX && 64 * 65 * 4 <= LDS_MAX, "LDS budget");
constexpr int MEGA_LDS = LDS_MAX + 16;
extern __shared__ __attribute__((aligned(16))) char dyn_smem[];

__device__ __forceinline__ int rotb(int vb, int k, int nb) { int v = vb + (k % nb); return v >= nb ? v - nb : v; }

typedef const __attribute__((address_space(4))) Params* KArgs;
__device__ __forceinline__ KArgs kargs() {
    KArgs r = (KArgs)__builtin_amdgcn_kernarg_segment_ptr();
    asm volatile("" : "+s"(r));
    return r;
}
#define KA (kargs())
template <int S, int SUB = 7>
__device__ __forceinline__ void run_stage(int l, char* smem, int vb, int nb, int WV) {
    const float* MODl = KA->MOD + (size_t)l * 2 * 6 * D;
    if (S == 0) {
        if (SUB == 1) phase_ada(KA->c, KA->c_ctx, KA->w_ada, KA->b_ada, KA->MOD, smem, vb, nb, WV);
        if (SUB == 2) phase_hy_filter(KA->hy_f_w1, KA->hy_f_b1, KA->hy_f_w2, KA->hy_f_b2, KA->hy_f_w3, KA->hy_f_freq, KA->hy_decay, KA->FILT,
                        KA->FILTC, smem, vb, nb, WV);
        if (SUB == 3) phase_init_h(KA->x, KA->ctx, KA->H, vb, nb, WV);
        if (SUB == 4) phase_s5_tables(KA->s5_a_re, KA->s5_a_im, KA->s5_log_step, KA->s5_b_re, KA->s5_b_im, KA->s5_c_re, KA->s5_c_im, KA->LAM,
                        KA->BBAR, KA->CSt, KA->CMb, KA->BBb, vb, nb, WV);
        if (SUB == 5) {
            for (int q = 0; q < DEPTH; ++q) {
                phase_wt_convert<1>(KA->w_in + (size_t)q * D * INW, D, INW, KA->WinT + (size_t)q * INP * D, INP, smem, rotb(vb, 64 * q, nb), nb, WV);
                phase_wt_convert<0>(KA->w_out + (size_t)q * D * D, D, D, KA->WoutT + (size_t)q * D * D, D, smem, rotb(vb, 64 * q + 32, nb), nb, WV);
                phase_wt_convert<0>(KA->peer_w_q + (size_t)q * D * D, D, D, KA->WqT + (size_t)q * D * D, D, smem, rotb(vb, 64 * q + 16, nb), nb, WV);
                phase_wt_convert<0>(KA->s5_w_glu + (size_t)q * DS5 * DS5, DS5, DS5, KA->WgluT + (size_t)q * DS5 * DS5, DS5, smem,
                                    rotb(vb, 64 * q + 48, nb), nb, WV);
            }
        }
        if (SUB == 6) {
            phase_convert(KA->peer_keys, KA->KEYSb, (size_t)DEPTH * PH * 2 * PKEYS * 128, vb, nb, WV);
            phase_convert_fp6(KA->peer_u, KA->U8, DEPTH * PEXP, PEER_US6, vb, nb, WV);
            phase_convert_fp6(KA->peer_v, KA->V8, DEPTH * PEXP, PEER_VS6, vb, nb, WV);
        }
    } else if (S == 1) {
        phase_modulate_bf16(KA->H, KA->g_norm1 + (size_t)l * D, MODl, 0, D, KA->A1b, vb, nb, WV);
    } else if (S == 2) {
        gemm_phase_t<false, 128, 1>(KA->A1b, D, KA->WinT + (size_t)l * INP * D, D, T / GBM, INP / GBN, D, smem, vb, nb, WV,
                   EpiInProj{KA->PB, KA->ALPHA, nullptr});
    } else if (S == 3) {
        if (SUB & 1) phase_gla_prep(KA->PB, KA->ALPHA, KA->gla_w_alpha + (size_t)l * 2 * RANK * DGK, KA->gla_b_alpha + (size_t)l * 2 * DGK,
                                    KA->GQD, KA->GKM, KA->GKMT, KA->GVT, KA->GBL, smem, vb, nb, WV);
        if (SUB & 2) phase_s5_scan<0>(l, KA->PB, KA->LAM, KA->BBb, KA->CMb, KA->s5_d + (size_t)l * DS5, KA->SE, nullptr, nullptr, nullptr, smem,
                         rotb(vb, 16, nb), nb, WV);
        if (SUB & 4) phase_hy_short(KA->PB, KA->hy_conv_w + (size_t)l * 3 * 1536, KA->hy_conv_b + (size_t)l * 1536, KA->X0b, KA->STb, smem,
                       rotb(vb, 80, nb), nb, WV);
    } else if (S == 4) {
        if (SUB & 1) phase_hy_conv(l, KA->FILT, KA->FILTC, KA->STb, KA->YTb, smem, vb, nb, WV);
        if (SUB & 2) phase_gla_carry(KA->SLOC, KA->DEC, KA->SIN, rotb(vb, 0, nb), nb, WV);
        if (SUB & 4) phase_s5_carry(l, KA->LAM, KA->SE, KA->HIN, rotb(vb, nb - 16, nb), nb, WV);
    } else if (S == 5) {
        if (SUB & 1) phase_gla2<1>(KA->GQD, KA->GKM, KA->GKMT, KA->GVT, KA->GBL, nullptr, nullptr, KA->SIN, KA->OGb, smem, vb, nb, WV);
        if (SUB & 4) {
            constexpr int G2 = GNS * 16 - 512;
            if (nb == 512 && G2 > 0 && G2 < 512) { if (vb >= G2) phase_hy_finish(KA->X0b, KA->STb, KA->YTb, KA->hy_bias + (size_t)l * DHY, KA->MIXb, nullptr, smem, vb - G2, nb - G2, WV); }
            else phase_hy_finish(KA->X0b, KA->STb, KA->YTb, KA->hy_bias + (size_t)l * DHY, KA->MIXb, nullptr, smem, rotb(vb, 80, nb), nb, WV);
        }
    } else if (S == 13) {
        if (SUB & 1) phase_s5_scan<1>(l, KA->PB, KA->LAM, KA->BBb, KA->CMb, KA->s5_d + (size_t)l * DS5, nullptr, KA->HIN, nullptr, KA->Zf, smem,
                         vb, nb, WV);
        if (SUB & 2) phase_gla_finish(KA->PB, KA->OGb, KA->gla_g_norm + (size_t)l * DV, KA->MIXb, nullptr, rotb(vb, 64, nb), nb, WV);
    } else if (S == 6) {
        phase_gla_finish(KA->PB, KA->OGb, KA->gla_g_norm + (size_t)l * DV, KA->MIXb, nullptr, rotb(vb, 264, nb), nb, WV);
        gemm_phase_t<true, 64, 0>(reinterpret_cast<const bf16_t*>(KA->Zf), DS5, KA->WgluT + (size_t)l * DS5 * DS5, DS5, T / 64, DS5 / GBN,
                           DS5, smem, vb, nb, WV, EpiGLU{KA->Zf, KA->s5_b_glu + (size_t)l * DS5, KA->MIXb, nullptr});
    } else if (S == 7) {
        gemm_phase_t<false, 96, 2>(KA->MIXb, D, KA->WoutT + (size_t)l * D * D, D, T / 96, D / GBN, D, smem, vb, nb, WV, EpiResid{KA->H, MODl, 2 * D});
    } else if (S == 8) {
        phase_modulate_bf16(KA->H, KA->g_norm2 + (size_t)l * D, MODl, 3 * D, 4 * D, KA->A1b, vb, nb, WV);
    } else if (S == 9) {
        gemm_phase_t<false, 96, 2>(KA->A1b, D, KA->WqT + (size_t)l * D * D, D, T / 96, D / GBN, D, smem, vb, nb, WV, EpiBf16{KA->Qb, D});
    } else if (S == 10) {
        phase_peer_select(KA->Qb, KA->KEYSb + (size_t)l * PH * 2 * PKEYS * 128, KA->IDX, KA->GATE, smem, vb, nb, WV);
    } else if (S == 11) {
        phase_peer_gather(KA->A1b, KA->IDX, KA->GATE, KA->U8 + (size_t)l * PEXP * PROW, KA->V8 + (size_t)l * PEXP * PROW, MODl, KA->H,
                          l == DEPTH - 1, KA->g_norm1 + (size_t)(l + 1 < DEPTH ? l + 1 : 0) * D,
                          KA->MOD + (size_t)(l + 1 < DEPTH ? l + 1 : 0) * 2 * 6 * D, KA->A1b, KA->g_final, KA->out, smem, vb, nb, WV);
    } else if (S == 16) {
        phase_gla2<0>(KA->GQD, KA->GKM, KA->GKMT, KA->GVT, KA->GBL, KA->SLOC, KA->DEC, nullptr, nullptr, smem, vb, nb, WV);
        phase_hy_conv(l, KA->FILT, KA->FILTC, KA->STb, KA->YTb, smem, rotb(vb, 192, nb), nb, WV);
        phase_s5_carry(l, KA->LAM, KA->SE, KA->HIN, rotb(vb, nb - 16, nb), nb, WV);
    } else if (S == 17) {
        phase_gla_carry(KA->SLOC, KA->DEC, KA->SIN, vb, nb, WV);
        phase_s5_scan<1>(l, KA->PB, KA->LAM, KA->BBb, KA->CMb, KA->s5_d + (size_t)l * DS5, nullptr, KA->HIN, nullptr, KA->Zf, smem, rotb(vb, 64, nb), nb,
                         WV);
    } else if (S == 12) {
        phase_final(KA->H, KA->g_final, KA->out, vb, nb, WV);
    }
}
#ifndef MK_MULTI
#define MK_MULTI 0
#endif
#if MK_MULTI
template <int S, int SUB>
__global__ void __launch_bounds__(NTHR, 2) k_stage(Params p_unused, int l) {
    run_stage<S, SUB>(l, dyn_smem, blockIdx.x, gridDim.x, __builtin_amdgcn_readfirstlane((int)(threadIdx.x >> 6)));
}
#endif
#if !MK_MULTI
__global__ void __launch_bounds__(NTHR, 2) k_mega(Params p_unused) {
    char* smem = dyn_smem;
    if (threadIdx.x == 0) *reinterpret_cast<uint4*>(dyn_smem + LDS_MAX) = make_uint4(0u, 0u, 0u, 0u);
    __syncthreads();
    XcdBarrier xb = xcd_barrier_post(KA->bar, (volatile LAS unsigned*)(dyn_smem + LDS_MAX));
    const int vb = blockIdx.x, nb = gridDim.x;
    const int wv = __builtin_amdgcn_readfirstlane((int)(threadIdx.x >> 6));
    const bool stream_first = (((vb >> 8) ^ (vb >> 3)) & 1) != 0;
    if (stream_first) {
        run_stage<0, 6>(0, smem, vb, nb, wv);
        run_stage<0, 5>(0, smem, vb, nb, wv);
    }
    run_stage<0, 1>(0, smem, vb, nb, wv);
    run_stage<0, 2>(0, smem, rotb(vb, 384, nb), nb, wv);
    run_stage<0, 3>(0, smem, rotb(vb, 400, nb), nb, wv);
    run_stage<0, 4>(0, smem, rotb(vb, 448, nb), nb, wv);
    if (!stream_first) {
        run_stage<0, 5>(0, smem, vb, nb, wv);
        run_stage<0, 6>(0, smem, vb, nb, wv);
    }
    grid_sync(xb);
    run_stage<1>(0, smem, vb, nb, wv); grid_sync(xb);
    for (int l = 0; l < DEPTH; ++l) {
        run_stage<2>(l, smem, vb, nb, wv); grid_sync(xb);
        run_stage<3, 7>(l, smem, vb, nb, wv); grid_sync(xb);
        run_stage<16>(l, smem, vb, nb, wv); grid_sync(xb);
        run_stage<17>(l, smem, vb, nb, wv); grid_sync(xb);
        run_stage<5, 5>(l, smem, vb, nb, wv); grid_sync(xb);
        run_stage<6>(l, smem, vb, nb, wv); grid_sync(xb);
        run_stage<7>(l, smem, vb, nb, wv); grid_sync(xb);
        run_stage<8>(l, smem, vb, nb, wv); grid_sync(xb);
        run_stage<9>(l, smem, vb, nb, wv); grid_sync(xb);
        run_stage<10>(l, smem, vb, nb, wv); grid_sync(xb);
        run_stage<11>(l, smem, vb, nb, wv);
        if (l + 1 < DEPTH) grid_sync(xb);
    }
}
#endif

extern "C" void kernel_launch(void* const* d_in, const int* in_sizes, int n_in, void* d_out, int out_size, void* d_ws,
                              size_t ws_size, hipStream_t stream) {
    Params p{};
    const float** inp = reinterpret_cast<const float**>(&p);
    for (int i = 0; i < 38; ++i) inp[i] = (const float*)d_in[i];
    p.out = (float*)d_out;

    char* wp = (char*)d_ws;
    auto alloc = [&](size_t bytes) { char* r = wp; wp += (bytes + 255) & ~(size_t)255; return r; };
    p.bar = (unsigned*)alloc((size_t)XCD_BAR_WORDS * 4);
    p.H = (float*)alloc((size_t)T * D * 4);
    p.MOD = (float*)alloc((size_t)DEPTH * 2 * 6 * D * 4);
    p.ALPHA = (float*)alloc((size_t)T * 32 * 4);
    p.SLOC = (float*)alloc((size_t)GNS * 16 * GLA_UNIT_F * 4);
    p.SIN = (float*)alloc((size_t)GNS * 16 * GLA_UNIT_F * 4);
    p.DEC = (float*)alloc((size_t)GNS * 8 * 128 * 4);
    p.GATE = (float*)alloc((size_t)T * 128 * 4);
    p.LAM = (float2*)alloc((size_t)DEPTH * 2 * G5 * PS * 8);
    p.BBAR = (float2*)alloc((size_t)DEPTH * 2 * G5 * PS * CG * 8);
    p.CSt = (float2*)alloc((size_t)DEPTH * 2 * G5 * PS * CG * 8);
    p.CMb = (bf16_t*)alloc((size_t)DEPTH * 2 * G5 * CG * 128 * 2);
    p.BBb = (bf16_t*)alloc((size_t)DEPTH * 2 * G5 * 128 * 32 * 2);
    p.GQD = (bf16_t*)alloc((size_t)2 * GH * GNC * 64 * 128 * 2);
    p.GKM = (bf16_t*)alloc((size_t)2 * GH * GNC * 64 * 128 * 2);
    p.GKMT = (bf16_t*)alloc((size_t)2 * GH * GNC * 128 * 64 * 2);
    p.GVT = (bf16_t*)alloc((size_t)2 * GH * GNC * 256 * 64 * 2);
    p.GBL = (float*)alloc((size_t)2 * GH * GNC * 128 * 4);
    p.SE = (float2*)alloc((size_t)2 * G5 * S5NC * PS * 8);
    p.HIN = (float2*)alloc((size_t)2 * G5 * S5NC * PS * 8);
    p.IDX = (int*)alloc((size_t)T * 128 * 4);
    p.WinT = (bf16_t*)alloc((size_t)DEPTH * INP * D * 2);
    p.WoutT = (bf16_t*)alloc((size_t)DEPTH * D * D * 2);
    p.WqT = (bf16_t*)alloc((size_t)DEPTH * D * D * 2);
    p.WgluT = (bf16_t*)alloc((size_t)DEPTH * DS5 * DS5 * 2);
    p.KEYSb = (bf16_t*)alloc((size_t)DEPTH * PH * 2 * PKEYS * 128 * 2);
    p.U8 = (unsigned char*)alloc((size_t)DEPTH * PEXP * D);
    p.V8 = (unsigned char*)alloc((size_t)DEPTH * PEXP * D);
    p.FILT = (bf16_t*)alloc((size_t)DEPTH * DHY * 16384 * 2);
    p.FILTC = (bf16_t*)alloc((size_t)DEPTH * DHY * 512 * 2);
    p.A1b = (bf16_t*)alloc((size_t)T * D * 2);
    p.PB = (bf16_t*)alloc((size_t)T * PBW * 2);
    p.Zf = (float*)alloc((size_t)T * DS5 * 4);
    p.MIXb = (bf16_t*)alloc((size_t)T * D * 2);
    p.OGb = (bf16_t*)alloc((size_t)2 * T * DGV * 2);
    p.X0b = (bf16_t*)alloc((size_t)T * DHY * 2);
    p.STb = (bf16_t*)alloc((size_t)DHY * T * 2);
    p.YTb = (bf16_t*)alloc((size_t)DHY * T * 2);
    p.Qb = (bf16_t*)alloc((size_t)T * D * 2);
    if ((size_t)(wp - (char*)d_ws) > ws_size) fprintf(stderr, "WS OVERFLOW %zu > %zu\n", (size_t)(wp - (char*)d_ws), ws_size);

    static int grid = 0;
    if (!grid) {
        int dev = 0, cus = 0, per_cu = 0;
        (void)hipGetDevice(&dev);
        (void)hipDeviceGetAttribute(&cus, hipDeviceAttributeMultiprocessorCount, dev);
#if MK_MULTI
        per_cu = 2;
#else
        (void)hipFuncSetAttribute((const void*)k_mega, hipFuncAttributeMaxDynamicSharedMemorySize, MEGA_LDS);
        (void)hipOccupancyMaxActiveBlocksPerMultiprocessor(&per_cu, (const void*)k_mega, NTHR, MEGA_LDS);
#endif
        if (cus <= 0) cus = 256;
        grid = cus * (per_cu < 2 ? (per_cu < 1 ? 1 : per_cu) : 2);
    }
    (void)hipMemsetAsync(p.bar, 0, (size_t)XCD_BAR_WORDS * 4, stream);
#if MK_MULTI
    {
        static bool at = false;
#define SA(S, M) (void)hipFuncSetAttribute((const void*)k_stage<S, M>, hipFuncAttributeMaxDynamicSharedMemorySize, MEGA_LDS)
        if (!at) { at = true; SA(0,7); SA(1,7); SA(2,7); SA(3,7); SA(4,7); SA(5,7); SA(13,7); SA(6,7); SA(7,7); SA(8,7); SA(9,7); SA(10,7); SA(11,7); SA(12,7); }
#undef SA
#define LS(S, M, L) k_stage<S, M><<<grid, NTHR, MEGA_LDS, stream>>>(p, L)
        LS(0, 7, 0);
        for (int l = 0; l < DEPTH; ++l) {
            LS(1, 7, l); LS(2, 7, l);
            LS(3, 7, l);
            LS(4, 7, l);
            LS(5, 7, l);
            LS(13, 7, l);
            LS(6, 7, l);
            LS(7, 7, l); LS(8, 7, l); LS(9, 7, l); LS(10, 7, l); LS(11, 7, l);
        }
        LS(12, 7, 0);
#undef LS
    }
#else
    k_mega<<<grid, NTHR, MEGA_LDS, stream>>>(p);
#endif
}
```

```cpp
#include <hip/hip_runtime.h>
#include <math.h>
#include <stdint.h>
#include <stdio.h>

constexpr int D = 2048, SEQ = 8192, CTX = 256, T = SEQ + CTX, DEPTH = 4;
constexpr int DS5 = 512, G5 = 32, CG = 16, PS = 64;
constexpr int GH = 4, DK = 128, DV = 256, DGK = 512, DGV = 1024, RANK = 16;
constexpr int DHY = 512, HYF = 33, HYH = 64;
constexpr int INW = 5152;
constexpr int O_S5 = 0, O_Q = 512, O_K = 1024, O_V = 1536, O_GATE = 2560, O_ALPHA = 3584, O_HY = 3616;
constexpr int PH = 8, PKEYS = 128, PDQ = 256, PTOP = 16, PEXP = 16384;
constexpr float EPS = 1e-6f;

__device__ __forceinline__ float gelu_f(float x) {
    return 0.5f * x * (1.f + tanhf(0.7978845608028654f * (x + 0.044715f * x * x * x)));
}
__device__ __forceinline__ float sigmoid_f(float x) { return 1.f / (1.f + expf(-x)); }
__device__ __forceinline__ float silu_f(float x) { return x * sigmoid_f(x); }
__device__ __forceinline__ float logsigmoid_f(float x) { return fminf(x, 0.f) - log1pf(expf(-fabsf(x))); }

__device__ __forceinline__ float wave_sum(float v, int lane) {
#pragma unroll
    for (int o = 32; o > 0; o >>= 1) v += __int_as_float(__builtin_amdgcn_ds_bpermute((lane ^ o) << 2, __float_as_int(v)));
    return v;
}

__device__ __forceinline__ int ltid(int wv) {
    unsigned z = 0u;
    asm volatile("" : "+s"(z));
    int t = (wv << 6) | (int)__builtin_amdgcn_mbcnt_hi(~0u, __builtin_amdgcn_mbcnt_lo(~0u, z));
    asm volatile("" : "+v"(t));
    return t;
}


__device__ __forceinline__ int scan_row(int dr, int j) {
    return dr == 0 ? j : (j < CTX ? CTX - 1 - j : (T + CTX - 1) - j);
}

typedef unsigned short bf16_t;
typedef __attribute__((ext_vector_type(8))) short bf16x8;
typedef __attribute__((ext_vector_type(4))) float f32x4;
#define NTHR 256

__device__ __forceinline__ bf16_t f2bf(float f) {
    unsigned u = __float_as_uint(f);
    u += 0x7fffu + ((u >> 16) & 1u);
    return (bf16_t)(u >> 16);
}
__device__ __forceinline__ float bf2f(bf16_t b) { return __uint_as_float(((unsigned)b) << 16); }
__device__ __forceinline__ unsigned pack2bf(float lo, float hi) { return (unsigned)f2bf(lo) | ((unsigned)f2bf(hi) << 16); }

__device__ __forceinline__ int win_src_col(int n_out) {
    if (n_out < 3584) return n_out;
    if (n_out < 5120) return n_out + 32;
    if (n_out < 5152) return n_out - 1536;
    return -1;
}
template <int PERM>
__device__ __forceinline__ void phase_wt_convert(const float* __restrict__ W, int K, int N, bf16_t* __restrict__ Wt, int Nout, char* smem,
                                 int vb, int nb, int WV) {
    const int TIDX = ltid(WV);
    float* tile = (float*)smem;
    const int tilesN = Nout / 64, tilesK = K / 64, ntl = tilesN * tilesK;
    const int kq = TIDX >> 4, n4 = (TIDX & 15) * 4;
    float4 r0, r1, r2, r3;
#define WT_LOAD(TL)                                                                                             \
    {                                                                                                           \
        const int tn_ = (TL) / tilesK, tk_ = (TL) % tilesK, n_out = tn_ * 64 + n4;                              \
        const int src = PERM ? win_src_col(n_out) : (n_out < N ? n_out : -1);                                   \
        const float* wp = W + (size_t)(tk_ * 64 + kq) * N + (src >= 0 ? src : 0);                               \
        r0 = make_float4(0.f, 0.f, 0.f, 0.f); r1 = r0; r2 = r0; r3 = r0;                                        \
        if (src >= 0) {                                                                                         \
            r0 = *reinterpret_cast<const float4*>(wp);                                                          \
            r1 = *reinterpret_cast<const float4*>(wp + (size_t)16 * N);                                         \
            r2 = *reinterpret_cast<const float4*>(wp + (size_t)32 * N);                                         \
            r3 = *reinterpret_cast<const float4*>(wp + (size_t)48 * N);                                         \
        }                                                                                                       \
    }
    int t = vb;
    if (t < ntl) WT_LOAD(t)
    while (t < ntl) {
        const int tn = t / tilesK, tk = t % tilesK;
        __syncthreads();
        {
            float* tp = tile + kq * 65 + n4;
            tp[0] = r0.x; tp[1] = r0.y; tp[2] = r0.z; tp[3] = r0.w;
            tp[16 * 65 + 0] = r1.x; tp[16 * 65 + 1] = r1.y; tp[16 * 65 + 2] = r1.z; tp[16 * 65 + 3] = r1.w;
            tp[32 * 65 + 0] = r2.x; tp[32 * 65 + 1] = r2.y; tp[32 * 65 + 2] = r2.z; tp[32 * 65 + 3] = r2.w;
            tp[48 * 65 + 0] = r3.x; tp[48 * 65 + 1] = r3.y; tp[48 * 65 + 2] = r3.z; tp[48 * 65 + 3] = r3.w;
        }
        const int tnext = t + nb;
        if (tnext < ntl) WT_LOAD(tnext)
        __syncthreads();
#pragma unroll
        for (int h = 0; h < 2; ++h) {
            const int nn = (TIDX >> 3) + 32 * h, k8 = (TIDX & 7) * 8;
            const float* tp = tile + k8 * 65 + nn;
            uint4 o;
            o.x = pack2bf(tp[0 * 65], tp[1 * 65]); o.y = pack2bf(tp[2 * 65], tp[3 * 65]);
            o.z = pack2bf(tp[4 * 65], tp[5 * 65]); o.w = pack2bf(tp[6 * 65], tp[7 * 65]);
            *reinterpret_cast<uint4*>(Wt + (size_t)(tn * 64 + nn) * K + tk * 64 + k8) = o;
        }
        t = tnext;
    }
#undef WT_LOAD
}
__device__ __forceinline__ void phase_convert(const float* __restrict__ src, bf16_t* __restrict__ dst, size_t n, int vb, int nb, int WV) {
    const int TIDX = ltid(WV);
    size_t n4 = n / 4;
    for (size_t i = (size_t)vb * NTHR + TIDX; i < n4; i += (size_t)nb * NTHR) {
        float4 v = reinterpret_cast<const float4*>(src)[i];
        uint2 o; o.x = pack2bf(v.x, v.y); o.y = pack2bf(v.z, v.w);
        reinterpret_cast<uint2*>(dst)[i] = o;
    }
}

constexpr int GBM = 128, GBN = 128, GBK = 64, GLD = 72;
constexpr int GEMM_LDS = 2 * 2 * GBM * GLD * 2;

template <bool AF32>
__device__ __forceinline__ uint4 lda_chunk(const bf16_t* Ag, const float* Af, size_t off) {
    if (!AF32) return *reinterpret_cast<const uint4*>(Ag + off);
    const float4 lo = *reinterpret_cast<const float4*>(Af + off), hi = *reinterpret_cast<const float4*>(Af + off + 4);
    return make_uint4(pack2bf(lo.x, lo.y), pack2bf(lo.z, lo.w), pack2bf(hi.x, hi.y), pack2bf(hi.z, hi.w));
}
template <int ORD>
__device__ __forceinline__ void gemm_tile_coords(int i, int Mtiles, int& tm, int& tn) {
    if (ORD == 1) {
        if (i < 5 * 528) {
            const int stn = i / 528, r = i % 528;
            if (r < 512) { const int stm = r >> 6, w = r & 63; tm = stm * 8 + (w & 7); tn = stn * 8 + (w >> 3); }
            else { const int w = r - 512; tm = 64 + (w & 1); tn = stn * 8 + (w >> 1); }
        } else { tm = i - 5 * 528; tn = 40; }
    } else if (ORD == 2) {
        const int stn = i / 704, r = i % 704, stm = r >> 6, w = r & 63;
        tm = stm * 8 + (w & 7); tn = stn * 8 + (w >> 3);
    } else { tn = i / Mtiles; tm = i % Mtiles; }
}
template <bool AF32, int BMT, int ORD, class Epi>
__device__ __forceinline__ void gemm_phase_t(const bf16_t* __restrict__ A, int lda, const bf16_t* __restrict__ Bt, int ldb, int Mtiles,
                           int Ntiles, int K, char* smem, int vb, int nb, int WV, Epi epi) {
    const int TIDX = ltid(WV);
    constexpr int MI = BMT / 32;
    bf16_t* lds = (bf16_t*)smem;
    const int tid = TIDX, wave = tid >> 6, lane = tid & 63, lr = lane & 15, lq = lane >> 4;
    const int wm = wave >> 1, wn = wave & 1;
    const int ldrow = tid >> 3, ldk = (tid & 7) * 8;
    const int KT = K / GBK;
    const int ntiles = Mtiles * Ntiles;
    const int per_x = (ntiles + 7) >> 3, xq = vb >> 3, xstride = nb >> 3;
    const int t_begin = ORD ? (vb & 7) * per_x + xq : vb;
    const int t_end = ORD ? (((vb & 7) + 1) * per_x < ntiles ? ((vb & 7) + 1) * per_x : ntiles) : ntiles;
    const int t_step = ORD ? xstride : nb;
    for (int tile = t_begin; tile < t_end; tile += t_step) {
        int tm, tn;
        gemm_tile_coords<ORD>(tile, Mtiles, tm, tn);
        const bf16_t* Ag = A + (size_t)(tm * BMT + ldrow) * lda + ldk;
        const float* Af = reinterpret_cast<const float*>(A) + (size_t)(tm * BMT + ldrow) * lda + ldk;
        const bf16_t* Bg = Bt + (size_t)(tn * GBN + ldrow) * ldb + ldk;
        f32x4 acc[MI][4];
#pragma unroll
        for (int i = 0; i < MI; ++i)
#pragma unroll
            for (int j = 0; j < 4; ++j) acc[i][j] = (f32x4){0.f, 0.f, 0.f, 0.f};
        uint4 xa0, xa1, xa2, xa3, xb0, xb1, xb2, xb3, ya0, ya1, ya2, ya3, yb0, yb1, yb2, yb3;
        xa3 = make_uint4(0u, 0u, 0u, 0u); ya3 = xa3; xa2 = xa3; ya2 = xa3;
#define G_LOAD(P, KOFF)                                                                        \
        P##a0 = lda_chunk<AF32>(Ag, Af, (size_t)(0) * lda + (KOFF));                           \
        P##a1 = lda_chunk<AF32>(Ag, Af, (size_t)(32) * lda + (KOFF));                          \
        if (MI >= 3) P##a2 = lda_chunk<AF32>(Ag, Af, (size_t)(64) * lda + (KOFF));             \
        if (MI == 4) P##a3 = lda_chunk<AF32>(Ag, Af, (size_t)(96) * lda + (KOFF));             \
        P##b0 = *reinterpret_cast<const uint4*>(Bg + (size_t)(0) * ldb + (KOFF));              \
        P##b1 = *reinterpret_cast<const uint4*>(Bg + (size_t)(32) * ldb + (KOFF));             \
        P##b2 = *reinterpret_cast<const uint4*>(Bg + (size_t)(64) * ldb + (KOFF));             \
        P##b3 = *reinterpret_cast<const uint4*>(Bg + (size_t)(96) * ldb + (KOFF));
#define G_STORE(P, BUF)                                                                                    \
        *reinterpret_cast<uint4*>(lds + (((BUF) * 2 + 0) * GBM + ldrow + 0) * GLD + ldk) = P##a0;          \
        *reinterpret_cast<uint4*>(lds + (((BUF) * 2 + 0) * GBM + ldrow + 32) * GLD + ldk) = P##a1;         \
        if (MI >= 3) *reinterpret_cast<uint4*>(lds + (((BUF) * 2 + 0) * GBM + ldrow + 64) * GLD + ldk) = P##a2; \
        if (MI == 4) *reinterpret_cast<uint4*>(lds + (((BUF) * 2 + 0) * GBM + ldrow + 96) * GLD + ldk) = P##a3; \
        *reinterpret_cast<uint4*>(lds + (((BUF) * 2 + 1) * GBM + ldrow + 0) * GLD + ldk) = P##b0;          \
        *reinterpret_cast<uint4*>(lds + (((BUF) * 2 + 1) * GBM + ldrow + 32) * GLD + ldk) = P##b1;         \
        *reinterpret_cast<uint4*>(lds + (((BUF) * 2 + 1) * GBM + ldrow + 64) * GLD + ldk) = P##b2;         \
        *reinterpret_cast<uint4*>(lds + (((BUF) * 2 + 1) * GBM + ldrow + 96) * GLD + ldk) = P##b3;
#define G_COMPUTE(BUF)                                                                                     \
        {                                                                                                  \
            const bf16_t* As = lds + ((BUF) * 2 + 0) * GBM * GLD;                                          \
            const bf16_t* Bs = lds + ((BUF) * 2 + 1) * GBM * GLD;                                          \
            _Pragma("unroll") for (int ks = 0; ks < 2; ++ks) {                                             \
                bf16x8 af[MI], bfr[4];                                                                     \
                _Pragma("unroll") for (int i = 0; i < MI; ++i)                                             \
                    af[i] = *reinterpret_cast<const bf16x8*>(As + (wm * (BMT / 2) + i * 16 + lr) * GLD + ks * 32 + lq * 8); \
                _Pragma("unroll") for (int i = 0; i < 4; ++i)                                              \
                    bfr[i] = *reinterpret_cast<const bf16x8*>(Bs + (wn * 64 + i * 16 + lr) * GLD + ks * 32 + lq * 8);       \
                __builtin_amdgcn_s_setprio(1);     \
                _Pragma("unroll") for (int i = 0; i < MI; ++i)                                             \
                    _Pragma("unroll") for (int j = 0; j < 4; ++j)                                          \
                        acc[i][j] = __builtin_amdgcn_mfma_f32_16x16x32_bf16(af[i], bfr[j], acc[i][j], 0, 0, 0);             \
                __builtin_amdgcn_s_setprio(0);                                                             \
            }                                                                                              \
        }
        G_LOAD(x, 0)
        G_LOAD(y, GBK)
        __syncthreads();
        G_STORE(x, 0)
        __syncthreads();
        for (int kt = 0; kt + 2 < KT; kt += 2) {
            G_LOAD(x, (kt + 2) * GBK)
            G_COMPUTE(0)
            G_STORE(y, 1)
            __syncthreads();
            G_LOAD(y, (kt + 3) * GBK)
            G_COMPUTE(1)
            G_STORE(x, 0)
            __syncthreads();
        }
        G_COMPUTE(0)
        G_STORE(y, 1)
        __syncthreads();
        G_COMPUTE(1)
#undef G_LOAD
#undef G_STORE
#undef G_COMPUTE
#pragma unroll
        for (int i = 0; i < MI; ++i)
#pragma unroll
            for (int j = 0; j < 4; ++j)
                epi(tm * BMT + wm * (BMT / 2) + i * 16 + lq * 4, tn * GBN + wn * 64 + j * 16 + lr, acc[i][j]);
    }
    __syncthreads();
}

template <class Epi>
__device__ __forceinline__ void gemm_phase(const bf16_t* A, int lda, const bf16_t* Bt, int ldb, int Mtiles, int Ntiles, int K,
                                           char* smem, int vb, int nb, int WV, Epi epi) {
    gemm_phase_t<false, 128, 0>(A, lda, Bt, ldb, Mtiles, Ntiles, K, smem, vb, nb, WV, epi);
}
struct EpiF32 {
    float* C; int ldc; int N;
    __device__ __forceinline__ void operator()(int m, int n, const f32x4& a) const {
        if (n < N) {
#pragma unroll
            for (int r = 0; r < 4; ++r) C[(size_t)(m + r) * ldc + n] = a[r];
        }
    }
};
struct EpiResid {
    float* H; const float* MODl; int gate_off;
    __device__ __forceinline__ void operator()(int m, int n, const f32x4& a) const {
        const float gt = MODl[(size_t)(m < CTX ? 1 : 0) * 6 * D + gate_off + n];
#pragma unroll
        for (int r = 0; r < 4; ++r) H[(size_t)(m + r) * D + n] += gt * a[r];
    }
};

__device__ __forceinline__ void phase_modulate_bf16(const float* __restrict__ H, const float* __restrict__ g, const float* __restrict__ MODl,
                                    int shift_off, int scale_off, bf16_t* __restrict__ OUT, int vb, int nb, int WV) {
    const int TIDX = ltid(WV);
    const int wave = TIDX >> 6, lane = TIDX & 63;
    for (int row = vb * 4 + wave; row < T; row += nb * 4) {
        const float* h = H + (size_t)row * D;
        float4 v[8];
        float ss = 0.f;
#pragma unroll
        for (int i = 0; i < 8; ++i) {
            v[i] = *reinterpret_cast<const float4*>(h + i * 256 + lane * 4);
            ss += v[i].x * v[i].x + v[i].y * v[i].y + v[i].z * v[i].z + v[i].w * v[i].w;
        }
        ss = wave_sum(ss, lane);
        const float rs = rsqrtf(ss / D + EPS);
        const float* m = MODl + (size_t)(row < CTX ? 1 : 0) * 6 * D;
#pragma unroll
        for (int i = 0; i < 8; ++i) {
            const int d = i * 256 + lane * 4;
            const float4 gg = *reinterpret_cast<const float4*>(g + d);
            const float4 sc = *reinterpret_cast<const float4*>(m + scale_off + d);
            const float4 sh = *reinterpret_cast<const float4*>(m + shift_off + d);
            uint2 o;
            o.x = pack2bf(v[i].x * rs * gg.x * (1.f + sc.x) + sh.x, v[i].y * rs * gg.y * (1.f + sc.y) + sh.y);
            o.y = pack2bf(v[i].z * rs * gg.z * (1.f + sc.z) + sh.z, v[i].w * rs * gg.w * (1.f + sc.w) + sh.w);
            *reinterpret_cast<uint2*>(OUT + (size_t)row * D + d) = o;
        }
    }
}


__device__ __forceinline__ float bflo(unsigned w) { return __uint_as_float(w << 16); }
__device__ __forceinline__ float bfhi(unsigned w) { return __uint_as_float(w & 0xffff0000u); }
__device__ __forceinline__ float dot8(const uint4& u, const float* xf) {
    return bflo(u.x) * xf[0] + bfhi(u.x) * xf[1] + bflo(u.y) * xf[2] + bfhi(u.y) * xf[3] + bflo(u.z) * xf[4] + bfhi(u.z) * xf[5] +
           bflo(u.w) * xf[6] + bfhi(u.w) * xf[7];
}
__device__ __forceinline__ void axpy8(const uint4& v, float w, float* o) {
    o[0] += w * bflo(v.x); o[1] += w * bfhi(v.x); o[2] += w * bflo(v.y); o[3] += w * bfhi(v.y);
    o[4] += w * bflo(v.z); o[5] += w * bfhi(v.z); o[6] += w * bflo(v.w); o[7] += w * bfhi(v.w);
}
constexpr float PEER_USCALE = 512.f;
__device__ __forceinline__ unsigned cvt4_fp8(f32x4 v, float scale) {
    const float a = __builtin_amdgcn_fmed3f(v[0] * scale, -448.f, 448.f), b = __builtin_amdgcn_fmed3f(v[1] * scale, -448.f, 448.f);
    const float c = __builtin_amdgcn_fmed3f(v[2] * scale, -448.f, 448.f), d = __builtin_amdgcn_fmed3f(v[3] * scale, -448.f, 448.f);
    int w = __builtin_amdgcn_cvt_pk_fp8_f32(a, b, 0, false);
    w = __builtin_amdgcn_cvt_pk_fp8_f32(c, d, w, true);
    return (unsigned)w;
}
__device__ __forceinline__ void phase_convert_fp8(const float* __restrict__ src, unsigned* __restrict__ dst, size_t n, float scale,
                                                  int vb, int nb, int WV) {
    const int TIDX = ltid(WV);
    const int nchunk = (int)(n / (4 * 8 * NTHR));
    for (int ch = vb; ch < nchunk; ch += nb) {
        const f32x4* sp = reinterpret_cast<const f32x4*>(src) + (size_t)ch * (8 * NTHR) + TIDX;
        unsigned* dp = dst + (size_t)ch * (8 * NTHR) + TIDX;
        const f32x4 v0 = __builtin_nontemporal_load(sp + 0 * NTHR), v1 = __builtin_nontemporal_load(sp + 1 * NTHR);
        const f32x4 v2 = __builtin_nontemporal_load(sp + 2 * NTHR), v3 = __builtin_nontemporal_load(sp + 3 * NTHR);
        const f32x4 v4 = __builtin_nontemporal_load(sp + 4 * NTHR), v5 = __builtin_nontemporal_load(sp + 5 * NTHR);
        const f32x4 v6 = __builtin_nontemporal_load(sp + 6 * NTHR), v7 = __builtin_nontemporal_load(sp + 7 * NTHR);
        dp[0 * NTHR] = cvt4_fp8(v0, scale); dp[1 * NTHR] = cvt4_fp8(v1, scale); dp[2 * NTHR] = cvt4_fp8(v2, scale);
        dp[3 * NTHR] = cvt4_fp8(v3, scale); dp[4 * NTHR] = cvt4_fp8(v4, scale); dp[5 * NTHR] = cvt4_fp8(v5, scale);
        dp[6 * NTHR] = cvt4_fp8(v6, scale); dp[7 * NTHR] = cvt4_fp8(v7, scale);
    }
}
typedef float f32x2_t __attribute__((ext_vector_type(2)));
typedef float v16f_t __attribute__((ext_vector_type(16)));
typedef float v32f_t __attribute__((ext_vector_type(32)));
typedef unsigned v6u_t __attribute__((ext_vector_type(6)));
constexpr int PROW = 1024;
constexpr float PEER_US6 = 90.5f, PEER_VS6 = 2.0f;
#ifndef F6_INTERLEAVED
#define F6_INTERLEAVED 0
#endif
__host__ __device__ constexpr int f6_q(int i) { return F6_INTERLEAVED ? ((i & 1) ? 16 + (i >> 1) : (i >> 1)) : i; }
__device__ __forceinline__ void phase_convert_fp6(const float* __restrict__ src, unsigned char* __restrict__ dst, int nrows, float scale,
                                                  int vb, int nb, int WV) {
    const int TIDX = ltid(WV);
    const int lane = TIDX & 63;
    for (int row = vb * 4 + WV; row < nrows; row += nb * 4) {
        const f32x4* sp = reinterpret_cast<const f32x4*>(src + (size_t)row * D) + lane;
        f32x4 q[8];
#pragma unroll
        for (int g = 0; g < 8; ++g) q[g] = __builtin_nontemporal_load(sp + g * 64);
        unsigned w[4] = {0u, 0u, 0u, 0u};
#pragma unroll
        for (int g = 0; g < 8; ++g) {
            const float c0 = __builtin_amdgcn_fmed3f(q[g][0] * scale, -6.f, 6.f), c1 = __builtin_amdgcn_fmed3f(q[g][1] * scale, -6.f, 6.f);
            const float c2 = __builtin_amdgcn_fmed3f(q[g][2] * scale, -6.f, 6.f), c3 = __builtin_amdgcn_fmed3f(q[g][3] * scale, -6.f, 6.f);
            if (g & 1) {
                w[g >> 1] = __builtin_amdgcn_cvt_scalef32_pk_fp4_f32(w[g >> 1], c0, c1, 1.0f, 2);
                w[g >> 1] = __builtin_amdgcn_cvt_scalef32_pk_fp4_f32(w[g >> 1], c2, c3, 1.0f, 3);
            } else {
                w[g >> 1] = __builtin_amdgcn_cvt_scalef32_pk_fp4_f32(w[g >> 1], c0, c1, 1.0f, 0);
                w[g >> 1] = __builtin_amdgcn_cvt_scalef32_pk_fp4_f32(w[g >> 1], c2, c3, 1.0f, 1);
            }
        }
        *reinterpret_cast<uint4*>(dst + (size_t)row * PROW + lane * 16) = make_uint4(w[0], w[1], w[2], w[3]);
    }
}
typedef uint4 prow_t;
__device__ __forceinline__ prow_t ld_f6(const unsigned char* p) { return *reinterpret_cast<const uint4*>(p); }
__device__ __forceinline__ float dot32_f6(const prow_t& u, const float (&xp)[32]) {
    const unsigned w[4] = {u.x, u.y, u.z, u.w};
    f32x2_t s2 = (f32x2_t){0.f, 0.f};
#pragma unroll
    for (int j = 0; j < 4; ++j) {
        s2 += __builtin_amdgcn_cvt_scalef32_pk_f32_fp4(w[j], 1.0f, 0) * (f32x2_t){xp[j * 8 + 0], xp[j * 8 + 1]};
        s2 += __builtin_amdgcn_cvt_scalef32_pk_f32_fp4(w[j], 1.0f, 1) * (f32x2_t){xp[j * 8 + 2], xp[j * 8 + 3]};
        s2 += __builtin_amdgcn_cvt_scalef32_pk_f32_fp4(w[j], 1.0f, 2) * (f32x2_t){xp[j * 8 + 4], xp[j * 8 + 5]};
        s2 += __builtin_amdgcn_cvt_scalef32_pk_f32_fp4(w[j], 1.0f, 3) * (f32x2_t){xp[j * 8 + 6], xp[j * 8 + 7]};
    }
    return s2[0] + s2[1];
}
__device__ __forceinline__ void axpy32_f6(const prow_t& v, float wgt, float (&o)[32]) {
    const unsigned w[4] = {v.x, v.y, v.z, v.w};
#pragma unroll
    for (int j = 0; j < 4; ++j) {
#pragma unroll
        for (int b = 0; b < 4; ++b) {
            f32x2_t d;
            if (b == 0) d = __builtin_amdgcn_cvt_scalef32_pk_f32_fp4(w[j], 1.0f, 0);
            else if (b == 1) d = __builtin_amdgcn_cvt_scalef32_pk_f32_fp4(w[j], 1.0f, 1);
            else if (b == 2) d = __builtin_amdgcn_cvt_scalef32_pk_f32_fp4(w[j], 1.0f, 2);
            else d = __builtin_amdgcn_cvt_scalef32_pk_f32_fp4(w[j], 1.0f, 3);
            o[j * 8 + b * 2 + 0] += wgt * d[0];
            o[j * 8 + b * 2 + 1] += wgt * d[1];
        }
    }
}
__device__ __forceinline__ float dot16_fp8(const uint4& u, const float* xf) {
    const unsigned w[4] = {u.x, u.y, u.z, u.w};
    f32x2_t s2 = (f32x2_t){0.f, 0.f};
#pragma unroll
    for (int q = 0; q < 4; ++q) {
        const f32x2_t lo = __builtin_amdgcn_cvt_pk_f32_fp8((int)w[q], false);
        const f32x2_t hi = __builtin_amdgcn_cvt_pk_f32_fp8((int)w[q], true);
        s2 += lo * (f32x2_t){xf[q * 4 + 0], xf[q * 4 + 1]};
        s2 += hi * (f32x2_t){xf[q * 4 + 2], xf[q * 4 + 3]};
    }
    return s2[0] + s2[1];
}
__device__ __forceinline__ void axpy16_fp8(const uint4& v, float wgt, float* o) {
    const unsigned w[4] = {v.x, v.y, v.z, v.w};
#pragma unroll
    for (int q = 0; q < 4; ++q) {
        const auto lo = __builtin_amdgcn_cvt_pk_f32_fp8((int)w[q], false);
        const auto hi = __builtin_amdgcn_cvt_pk_f32_fp8((int)w[q], true);
        o[q * 4 + 0] += wgt * lo[0]; o[q * 4 + 1] += wgt * lo[1]; o[q * 4 + 2] += wgt * hi[0]; o[q * 4 + 3] += wgt * hi[1];
    }
}
__device__ __forceinline__ void peer_sort128(unsigned& k0, unsigned& k1, int lane) {
#pragma unroll
    for (int k = 2; k <= 128; k <<= 1) {
#pragma unroll
        for (int j = k >> 1; j > 0; j >>= 1) {
            if (j == 64) {
                const unsigned lo = k0 < k1 ? k0 : k1, hi = k0 < k1 ? k1 : k0;
                k0 = lo; k1 = hi;
            } else {
                const bool lower = (lane & j) == 0;
                const bool asc0 = k < 64 ? (lane & k) == 0 : true;
                const bool asc1 = k < 64 ? (lane & k) == 0 : (k == 64 ? false : true);
                const unsigned o0 = (unsigned)__builtin_amdgcn_ds_bpermute((lane ^ j) << 2, (int)k0);
                const unsigned o1 = (unsigned)__builtin_amdgcn_ds_bpermute((lane ^ j) << 2, (int)k1);
                const unsigned mn0 = k0 < o0 ? k0 : o0, mx0 = k0 < o0 ? o0 : k0;
                const unsigned mn1 = k1 < o1 ? k1 : o1, mx1 = k1 < o1 ? o1 : k1;
                k0 = (lower == asc0) ? mn0 : mx0;
                k1 = (lower == asc1) ? mn1 : mx1;
            }
        }
    }
}
template <bool MORE>
__device__ __forceinline__ void peer_batch(const unsigned char* __restrict__ U8, const unsigned char* __restrict__ V8, int e0, int lane,
                                           int id0, int id1, float g0, float g1, const float (&xf)[32], float (&acc)[32],
                                           prow_t (&ur)[4], prow_t (&vr)[4], int (&cur)[4]) {
    float a[4];
#pragma unroll
    for (int k = 0; k < 4; ++k) a[k] = dot32_f6(ur[k], xf);
    int idn[4] = {0, 0, 0, 0};
    if (MORE) {
#pragma unroll
        for (int k = 0; k < 4; ++k) {
            const int e = e0 + 4 + k;
            idn[k] = __builtin_amdgcn_readlane(e < 64 ? id0 : id1, e & 63);
            ur[k] = ld_f6(U8 + (size_t)(idn[k] >> 7) * PROW + lane * 16);
        }
    }
    const bool b5 = (lane & 32) != 0, b4 = (lane & 16) != 0;
    const float r0 = (b5 ? a[2] : a[0]) + __int_as_float(__builtin_amdgcn_ds_bpermute((lane ^ 32) << 2, __float_as_int(b5 ? a[0] : a[2])));
    const float r1 = (b5 ? a[3] : a[1]) + __int_as_float(__builtin_amdgcn_ds_bpermute((lane ^ 32) << 2, __float_as_int(b5 ? a[1] : a[3])));
    float v = (b4 ? r1 : r0) + __int_as_float(__builtin_amdgcn_ds_bpermute((lane ^ 16) << 2, __float_as_int(b4 ? r0 : r1)));
#pragma unroll
    for (int o = 8; o > 0; o >>= 1) v += __int_as_float(__builtin_amdgcn_ds_bpermute((lane ^ o) << 2, __float_as_int(v)));
    const int wv = __float_as_int(gelu_f(v * (1.f / PEER_US6)) * (1.f / PEER_VS6));
#pragma unroll
    for (int k = 0; k < 4; ++k) {
        const int slot = cur[k] & 127;
        const float gk = __int_as_float(__builtin_amdgcn_readlane(__float_as_int(slot < 64 ? g0 : g1), slot & 63));
        const float w = gk * __int_as_float(__builtin_amdgcn_readlane(wv, 16 * k));
        axpy32_f6(vr[k], w, acc);
        if (MORE) {
            vr[k] = ld_f6(V8 + (size_t)(idn[k] >> 7) * PROW + lane * 16);
            cur[k] = idn[k];
        }
    }
}
__device__ __forceinline__ void peer_experts(const bf16_t* X, const int* __restrict__ IDX, const float* __restrict__ GATE,
                                             const unsigned char* __restrict__ U8, const unsigned char* __restrict__ V8, int tok, int lane,
                                             int EB, int NE, float (&acc)[32]) {
    float xq[32];
#pragma unroll
    for (int g = 0; g < 8; ++g) {
        typedef unsigned u32x2nt_t __attribute__((ext_vector_type(2)));
        const u32x2nt_t xr2 = __builtin_nontemporal_load(reinterpret_cast<const u32x2nt_t*>(X + (size_t)tok * D + g * 256 + lane * 4));
        const uint2 xr = make_uint2(xr2[0], xr2[1]);
        xq[g * 4 + 0] = bflo(xr.x); xq[g * 4 + 1] = bfhi(xr.x); xq[g * 4 + 2] = bflo(xr.y); xq[g * 4 + 3] = bfhi(xr.y);
    }
    float xf[32];
#pragma unroll
    for (int i = 0; i < 32; ++i) xf[i] = xq[f6_q(i)];
#pragma unroll
    for (int i = 0; i < 32; ++i) acc[i] = 0.f;
    const size_t io0 = (size_t)tok * 128 + lane, io1 = io0 + 64;
    const float g0 = GATE[io0], g1 = GATE[io1];
    unsigned sk0 = ((unsigned)IDX[io0] << 7) | (unsigned)lane, sk1 = ((unsigned)IDX[io1] << 7) | (unsigned)(lane + 64);
    peer_sort128(sk0, sk1, lane);
    const int id0 = (int)sk0, id1 = (int)sk1;
    prow_t ur[4], vr[4];
    int cur[4];
#pragma unroll
    for (int k = 0; k < 4; ++k) {
        const int e = EB + k;
        cur[k] = __builtin_amdgcn_readlane(e < 64 ? id0 : id1, e & 63);
        ur[k] = ld_f6(U8 + (size_t)(cur[k] >> 7) * PROW + lane * 16);
        vr[k] = ld_f6(V8 + (size_t)(cur[k] >> 7) * PROW + lane * 16);
    }
#pragma unroll 1
    for (int e0 = EB; e0 < EB + NE - 4; e0 += 4) peer_batch<true>(U8, V8, e0, lane, id0, id1, g0, g1, xf, acc, ur, vr, cur);
    peer_batch<false>(U8, V8, EB + NE - 4, lane, id0, id1, g0, g1, xf, acc, ur, vr, cur);
}
__host__ __device__ constexpr int f6_i(int q) { return F6_INTERLEAVED ? (q < 16 ? 2 * q : 2 * (q - 16) + 1) : q; }
__device__ __forceinline__ void peer_finish(int tok, int lane, float (&acc)[32], const float* __restrict__ MODl, float* H, bool last,
                                            const float* gnext, const float* MODnext, bf16_t* A1next, const float* gfin, float* out) {
    const int cls = tok < CTX ? 1 : 0;
    const float* gt2 = MODl + (size_t)cls * 6 * D + 5 * D;
    float* h = H + (size_t)tok * D;
    float ss = 0.f;
    float hn[32];
#pragma unroll
    for (int g = 0; g < 8; ++g) {
        const int d = g * 256 + lane * 4;
        const f32x4 hv4 = __builtin_nontemporal_load(reinterpret_cast<const f32x4*>(h + d));
        float4 hv = make_float4(hv4[0], hv4[1], hv4[2], hv4[3]);
        const float4 gv = *reinterpret_cast<const float4*>(gt2 + d);
        hv.x += gv.x * acc[f6_i(g * 4 + 0)]; hv.y += gv.y * acc[f6_i(g * 4 + 1)];
        hv.z += gv.z * acc[f6_i(g * 4 + 2)]; hv.w += gv.w * acc[f6_i(g * 4 + 3)];
        __builtin_nontemporal_store((f32x4){hv.x, hv.y, hv.z, hv.w}, reinterpret_cast<f32x4*>(h + d));
        hn[g * 4 + 0] = hv.x; hn[g * 4 + 1] = hv.y; hn[g * 4 + 2] = hv.z; hn[g * 4 + 3] = hv.w;
        ss += hv.x * hv.x + hv.y * hv.y + hv.z * hv.z + hv.w * hv.w;
    }
    ss = wave_sum(ss, lane);
    const float rs = rsqrtf(ss / D + EPS);
    if (!last) {
        const float* m = MODnext + (size_t)cls * 6 * D;
#pragma unroll
        for (int g = 0; g < 8; ++g) {
            const int d = g * 256 + lane * 4;
            const float4 gg = *reinterpret_cast<const float4*>(gnext + d);
            const float4 sc = *reinterpret_cast<const float4*>(m + D + d);
            const float4 sh = *reinterpret_cast<const float4*>(m + d);
            const float* hv = hn + g * 4;
            uint2 o;
            o.x = pack2bf(hv[0] * rs * gg.x * (1.f + sc.x) + sh.x, hv[1] * rs * gg.y * (1.f + sc.y) + sh.y);
            o.y = pack2bf(hv[2] * rs * gg.z * (1.f + sc.z) + sh.z, hv[3] * rs * gg.w * (1.f + sc.w) + sh.w);
            typedef unsigned u32x2st_t __attribute__((ext_vector_type(2)));
            __builtin_nontemporal_store((u32x2st_t){o.x, o.y}, reinterpret_cast<u32x2st_t*>(A1next + (size_t)tok * D + d));
        }
    } else if (tok >= CTX) {
#pragma unroll
        for (int g = 0; g < 8; ++g) {
            const int d = g * 256 + lane * 4;
            const float4 gg = *reinterpret_cast<const float4*>(gfin + d);
            const float* hv = hn + g * 4;
            float4 o;
            o.x = hv[0] * rs * gg.x; o.y = hv[1] * rs * gg.y; o.z = hv[2] * rs * gg.z; o.w = hv[3] * rs * gg.w;
            __builtin_nontemporal_store((f32x4){o.x, o.y, o.z, o.w}, reinterpret_cast<f32x4*>(out + (size_t)(tok - CTX) * D + d));
        }
    }
}
__device__ __forceinline__ void phase_peer_gather(const bf16_t* X, const int* __restrict__ IDX, const float* __restrict__ GATE,
                                                  const unsigned char* __restrict__ U8, const unsigned char* __restrict__ V8,
                                                  const float* __restrict__ MODl, float* H, bool last, const float* gnext,
                                                  const float* MODnext, bf16_t* A1next, const float* gfin, float* out, char* smem, int vb, int nb,
                                                  int WV) {
    const int TIDX = ltid(WV);
    const int wave = TIDX >> 6, lane = TIDX & 63;
    for (int tok = vb * 4 + wave; tok < T; tok += nb * 4) {
        float acc[32];
        int ln = lane;
        asm volatile("" : "+v"(ln));
        peer_experts(X, IDX, GATE, U8, V8, tok, ln, 0, 128, acc);
        asm volatile("" : "+v"(ln));
        peer_finish(tok, ln, acc, MODl, H, last, gnext, MODnext, A1next, gfin, out);
    }
}

constexpr int PBW = 5120, PB_S5 = 0, PB_Q = 512, PB_K = 1024, PB_V = 1536, PB_GATE = 2560, PB_HY = 3584;
struct EpiInProj {
    bf16_t* PB; float* ALPHA; float* Pdev;
    __device__ __forceinline__ void operator()(int m, int n, const f32x4& a) const {
        if (n < PBW) {
#pragma unroll
            for (int r = 0; r < 4; ++r) PB[(size_t)(m + r) * PBW + n] = f2bf(a[r]);
        } else if (n < PBW + 32) {
#pragma unroll
            for (int r = 0; r < 4; ++r) ALPHA[(size_t)(m + r) * 32 + (n - PBW)] = a[r];
        }
        if (Pdev) {
            const int sc = win_src_col(n);
            if (sc >= 0) {
#pragma unroll
                for (int r = 0; r < 4; ++r) Pdev[(size_t)(m + r) * INW + sc] = a[r];
            }
        }
    }
};
struct EpiGLU {
    const float* Zf; const float* b; bf16_t* MIXb; float* MIXdev;
    __device__ __forceinline__ void operator()(int m, int n, const f32x4& a) const {
        const float bb = b[n];
#pragma unroll
        for (int r = 0; r < 4; ++r) {
            const float z = Zf[(size_t)(m + r) * DS5 + n];
            const float o = z * sigmoid_f(a[r] + bb);
            MIXb[(size_t)(m + r) * D + n] = f2bf(o);
            if (MIXdev) MIXdev[(size_t)(m + r) * D + n] = o;
        }
    }
};

constexpr int S5C = 64, S5NC = T / S5C;
__device__ __forceinline__ void phase_s5_tables(const float* a_re, const float* a_im, const float* log_step, const float* b_re,
                                                const float* b_im, const float* c_re, const float* c_im, float2* LAM,
                                                float2* BBAR, float2* CS, bf16_t* CMb, bf16_t* BBb, int vb, int nb, int WV) {
    const int TIDX = ltid(WV);
    for (int i = vb * NTHR + TIDX; i < DEPTH * 2 * G5 * PS; i += nb * NTHR) {
        const int p = i % PS, ldg = i / PS;
        const float ar = a_re[i], ai = a_im[i];
        const float dt = expf(log_step[ldg]);
        const float er = expf(ar * dt);
        const float lbr = er * cosf(ai * dt), lbi = er * sinf(ai * dt);
        const float nr = lbr - 1.f, ni = lbi, den = ar * ar + ai * ai;
        const float cfr = (nr * ar + ni * ai) / den, cfi = (ni * ar - nr * ai) / den;
        LAM[i] = make_float2(lbr, lbi);
        for (int c = 0; c < CG; ++c) {
            const float br = b_re[(size_t)i * CG + c], bi = b_im[(size_t)i * CG + c];
            BBAR[(size_t)i * CG + c] = make_float2(cfr * br - cfi * bi, cfr * bi + cfi * br);
            BBb[((size_t)ldg * 128 + p) * 32 + c] = f2bf(cfr * br - cfi * bi);
            BBb[((size_t)ldg * 128 + 64 + p) * 32 + c] = f2bf(cfr * bi + cfi * br);
            BBb[((size_t)ldg * 128 + p) * 32 + 16 + c] = 0;
            BBb[((size_t)ldg * 128 + 64 + p) * 32 + 16 + c] = 0;
            const size_t ci = ((size_t)ldg * CG + c) * PS + p;
            CS[(size_t)i * CG + c] = make_float2(c_re[ci], c_im[ci]);
            CMb[((size_t)ldg * CG + c) * 128 + p] = f2bf(c_re[ci]);
            CMb[((size_t)ldg * CG + c) * 128 + 64 + p] = f2bf(-c_im[ci]);
        }
    }
}
__device__ __forceinline__ int s5_chunk_index(int dir, int Rc) {
    if (dir == 0) return Rc;
    return (Rc < CTX / S5C) ? (CTX / S5C - 1 - Rc) : ((T + CTX) / S5C - 1 - Rc);
}
constexpr int S5_HB = 136;
template <int MODE>
__device__ __forceinline__ void phase_s5_scan(int l, const bf16_t* PB, const float2* LAM, const bf16_t* BBb, const bf16_t* CMb,
                                              const float* dvec, float2* SE, const float2* HIN, bf16_t* Zb, float* Zdev,
                                              char* smem, int vb, int nb, int WV) {
    const int TIDX = ltid(WV);
    bf16_t* Ub = (bf16_t*)smem;
    bf16_t* Hb = Ub + 64 * 32;
    float* Ys = (float*)(Hb + 4 * 16 * S5_HB);
    float* BU = Ys + 4 * 64 * 16;
    const int tid = TIDX, wave = tid >> 6, lane = tid & 63, lr = lane & 15, lq = lane >> 4;
    for (int unit = vb; unit < S5NC * 16; unit += nb) {
        const int Rc = unit >> 4, gp = unit & 15;
        const int g = gp * 2 + (wave >> 1), dir = wave & 1;
        const int r0 = Rc * S5C;
        const int ti = ((l * 2 + dir) * G5 + g) * PS + lane;
        __syncthreads();
        {
            const int t = tid >> 2, q = tid & 3;
            *reinterpret_cast<uint4*>(Ub + t * 32 + q * 8) = *reinterpret_cast<const uint4*>(PB + (size_t)(r0 + t) * PBW + PB_S5 + gp * 32 + q * 8);
        }
        bf16x8 cb[4];
        if (MODE == 1) {
            const bf16_t* cm = CMb + ((size_t)((l * 2 + dir) * G5 + g) * CG + lr) * 128 + lq * 8;
#pragma unroll
            for (int ks = 0; ks < 4; ++ks) cb[ks] = *reinterpret_cast<const bf16x8*>(cm + ks * 32);
        }
        const float2 lam = LAM[ti];
        bf16x8 bb[8];
        {
            const bf16_t* bp = BBb + ((size_t)((l * 2 + dir) * G5 + g) * 128 + lr) * 32 + lq * 8;
#pragma unroll
            for (int nt = 0; nt < 8; ++nt) bb[nt] = *reinterpret_cast<const bf16x8*>(bp + nt * 16 * 32);
        }
        const int cidx = s5_chunk_index(dir, Rc);
        float hr = 0.f, hi = 0.f;
        if (MODE == 1) { const float2 h0 = HIN[((size_t)(dir * G5 + g) * S5NC + cidx) * PS + lane]; hr = h0.x; hi = h0.y; }
        __syncthreads();
        bf16_t* hw = Hb + wave * 16 * S5_HB;
        float* buw = BU + wave * 16 * 128;
        for (int tt = 0; tt < S5C; ++tt) {
            if ((tt & 15) == 0) {
                __builtin_amdgcn_wave_barrier();
                const int tts = tt + lr, tla = dir == 0 ? tts : (S5C - 1 - tts);
                union { uint4 u; bf16x8 v; } ua;
                ua.u = make_uint4(0u, 0u, 0u, 0u);
                if (lq < 2) ua.u = *reinterpret_cast<const uint4*>(Ub + tla * 32 + (wave >> 1) * 16 + lq * 8);
#pragma unroll
                for (int nt = 0; nt < 8; ++nt) {
                    f32x4 d = (f32x4){0.f, 0.f, 0.f, 0.f};
                    d = __builtin_amdgcn_mfma_f32_16x16x32_bf16(ua.v, bb[nt], d, 0, 0, 0);
#pragma unroll
                    for (int r = 0; r < 4; ++r) buw[(4 * lq + r) * 128 + 16 * nt + lr] = d[r];
                }
                __builtin_amdgcn_wave_barrier();
            }
            const float bur = buw[(tt & 15) * 128 + lane], bui = buw[(tt & 15) * 128 + 64 + lane];
            float nhr = fmaf(lam.x, hr, fmaf(-lam.y, hi, bur));
            float hr1 = hr, hi1 = hi;
            asm volatile("" : "+v"(nhr), "+v"(hr1), "+v"(hi1));
            float nhi = fmaf(lam.x, hi1, fmaf(lam.y, hr1, bui));
            asm volatile("" : "+v"(nhi));
            hr = nhr; hi = nhi;
            if (MODE == 1) {
                hw[(tt & 15) * S5_HB + lane] = f2bf(hr);
                hw[(tt & 15) * S5_HB + 64 + lane] = f2bf(hi);
                if ((tt & 15) == 15) {
                    __builtin_amdgcn_wave_barrier();
                    f32x4 ya = (f32x4){0.f, 0.f, 0.f, 0.f};
#pragma unroll
                    for (int ks = 0; ks < 4; ++ks) {
                        const bf16x8 ha = *reinterpret_cast<const bf16x8*>(hw + lr * S5_HB + ks * 32 + lq * 8);
                        ya = __builtin_amdgcn_mfma_f32_16x16x32_bf16(ha, cb[ks], ya, 0, 0, 0);
                    }
#pragma unroll
                    for (int r = 0; r < 4; ++r) {
                        const int tts = (tt - 15) + 4 * lq + r;
                        const int tls = dir == 0 ? tts : (S5C - 1 - tts);
                        Ys[wave * 64 * 16 + tls * 16 + lr] = ya[r];
                    }
                    __builtin_amdgcn_wave_barrier();
                }
            }
        }
        if (MODE == 0) {
            SE[((size_t)(dir * G5 + g) * S5NC + cidx) * PS + lane] = make_float2(hr, hi);
        } else {
            __syncthreads();
            for (int e = tid; e < 64 * 32; e += NTHR) {
                const int t = e >> 5, chl = e & 31, gs = chl >> 4, c = chl & 15;
                const int ch = gp * 32 + chl;
                const float y = Ys[(gs * 2 + 0) * 64 * 16 + t * 16 + c] + Ys[(gs * 2 + 1) * 64 * 16 + t * 16 + c] +
                                dvec[ch] * bf2f(Ub[t * 32 + chl]);
                const float z = gelu_f(y);
                Zdev[(size_t)(r0 + t) * DS5 + ch] = z;
            }
        }
    }
}
constexpr int S5_LDS = 64 * 32 * 2 + 4 * 16 * S5_HB * 2 + 4 * 64 * 16 * 4 + 4 * 16 * 128 * 4;

__device__ __forceinline__ void phase_s5_carry(int l, const float2* LAM, const float2* SE, float2* HIN, int vb, int nb, int WV) {
    const int TIDX = ltid(WV);
    for (int i = vb * NTHR + TIDX; i < 2 * G5 * PS; i += nb * NTHR) {
        const int p = i % PS, dg = i / PS;
        float2 lm = LAM[(size_t)(l * 2 * G5 + dg) * PS + p];
#pragma unroll
        for (int s = 1; s < S5C; s <<= 1) {
            float a = fmaf(lm.x, lm.x, -lm.y * lm.y);
            float bx = lm.x, by = lm.y;
            asm volatile("" : "+v"(a), "+v"(bx), "+v"(by));
            const float b = 2.f * bx * by;
            lm = make_float2(a, b);
        }
        float hr = 0.f, hi = 0.f;
        const size_t base = (size_t)dg * S5NC * PS + p;
        for (int c0 = 0; c0 < S5NC; c0 += 12) {
            float2 e[12];
#pragma unroll
            for (int k = 0; k < 12; ++k) e[k] = SE[base + (size_t)(c0 + k) * PS];
#pragma unroll
            for (int k = 0; k < 12; ++k) {
                HIN[base + (size_t)(c0 + k) * PS] = make_float2(hr, hi);
                float nr = fmaf(lm.x, hr, fmaf(-lm.y, hi, e[k].x));
                float hr1 = hr, hi1 = hi;
                asm volatile("" : "+v"(nr), "+v"(hr1), "+v"(hi1));
                float ni = fmaf(lm.x, hi1, fmaf(lm.y, hr1, e[k].y));
                asm volatile("" : "+v"(ni));
                hr = nr; hi = ni;
            }
        }
    }
}
static_assert(S5NC % 12 == 0, "carry unroll");


constexpr int GSC = 192, GNS = T / GSC, GL_QD = 136, GL_KT = 72;
static_assert(GNS * GSC == T && GSC % 64 == 0, "gla superchunk");
constexpr int GLA_LDS = 4096 + 1024 + 512 + 2 * 64 * GL_QD * 2 + 2 * 128 * GL_KT * 2;
constexpr int GLA_UNIT_F = 4 * 64 * 64;
template <int MODE>
__device__ __forceinline__ void phase_gla(const bf16_t* PB, const float* ALPHA, const float* w_alpha, const float* b_alpha,
                                          float* SLOC, float* DEC, const float* SIN, bf16_t* OG, char* smem, int vb, int nb, int WV) {
    const int TIDX = ltid(WV);
    float* As = (float*)smem;
    float* Bt = (float*)(smem + 4096);
    float* EB = (float*)(smem + 5120);
    bf16_t* Qd = (bf16_t*)(smem + 5632);
    bf16_t* Km = Qd + 64 * GL_QD;
    bf16_t* Att = Km;
    bf16_t* KeT = Km + 64 * GL_QD;
    bf16_t* VT = KeT + 128 * GL_KT;
    const int tid = TIDX, wave = tid >> 6, lane = tid & 63, lr = lane & 15, lq = lane >> 4;
    const int k = tid & 127, half = tid >> 7;
    const float qscale = 0.08838834764831845f;
    for (int unit = vb; unit < GNS * 16; unit += nb) {
        const int vh = unit & 1, dir = (unit >> 1) & 1, head = (unit >> 2) & 3, sc = unit >> 4;
        f32x4 S[8][2];
#pragma unroll
        for (int m = 0; m < 8; ++m)
#pragma unroll
            for (int n = 0; n < 2; ++n) {
                if (MODE == 0) S[m][n] = (f32x4){0.f, 0.f, 0.f, 0.f};
                else {
#pragma unroll
                    for (int r = 0; r < 4; ++r)
                        S[m][n][r] = SIN[((size_t)(unit * 4 + wave) * 64 + (m * 2 + n) * 4 + r) * 64 + lane];
                }
            }
        float dsum = 0.f;
        for (int ci = 0; ci < GSC / 64; ++ci) {
            const int j0 = sc * GSC + ci * 64;
            float wcol[RANK];
#pragma unroll
            for (int r = 0; r < RANK; ++r) wcol[r] = w_alpha[(size_t)(dir * RANK + r) * DGK + head * DK + k];
            const float bcol = b_alpha[dir * DGK + head * DK + k];
            __syncthreads();
            for (int e = tid; e < 64 * 16; e += NTHR) {
                const int tt = e >> 4, r = e & 15;
                As[e] = ALPHA[(size_t)scan_row(dir, j0 + tt) * 32 + dir * 16 + r];
            }
            __syncthreads();
            float bl[32];
            {
                float b = 0.f;
#pragma unroll
                for (int i = 0; i < 32; ++i) {
                    const float* ar = As + (half * 32 + i) * 16;
                    float x = bcol;
#pragma unroll
                    for (int r = 0; r < RANK; ++r) x += ar[r] * wcol[r];
                    b += logsigmoid_f(x) * (1.f / 16.f);
                    bl[i] = b;
                }
                Bt[half * 128 + k] = b;
            }
            __syncthreads();
            const float b0 = Bt[k], blast = b0 + Bt[128 + k];
            if (half == 0) { EB[k] = expf(blast); dsum += blast; }
#pragma unroll
            for (int i = 0; i < 32; ++i) {
                if ((i & 7) == 0) asm volatile("" ::: "memory");
                const int tt = half * 32 + i;
                const float bb = bl[i] + (half ? b0 : 0.f);
                const bf16_t* pr = PB + (size_t)scan_row(dir, j0 + tt) * PBW;
                const float kv = bf2f(pr[PB_K + head * DK + k]);
                KeT[k * GL_KT + tt] = f2bf(kv * expf(blast - bb));
                if (MODE == 1) {
                    const float qv = bf2f(pr[PB_Q + head * DK + k]);
                    const float ee = expf(bb);
                    Qd[tt * GL_QD + k] = f2bf(qv * ee * qscale);
                    Km[tt * GL_QD + k] = f2bf(kv / ee);
                }
                VT[k * GL_KT + tt] = pr[PB_V + head * DV + vh * 128 + k];
            }
            __syncthreads();
            bf16x8 vtf[2][2];
#pragma unroll
            for (int ks = 0; ks < 2; ++ks)
#pragma unroll
                for (int n = 0; n < 2; ++n)
                    vtf[ks][n] = *reinterpret_cast<const bf16x8*>(VT + (32 * wave + 16 * n + lr) * GL_KT + ks * 32 + lq * 8);
            if (MODE == 1) {
                f32x4 at[4];
#pragma unroll
                for (int n = 0; n < 4; ++n) at[n] = (f32x4){0.f, 0.f, 0.f, 0.f};
#pragma unroll
                for (int ks = 0; ks < 4; ++ks) {
                    const bf16x8 a = *reinterpret_cast<const bf16x8*>(Qd + (16 * wave + lr) * GL_QD + ks * 32 + lq * 8);
#pragma unroll
                    for (int n = 0; n < 4; ++n) {
                        const bf16x8 bq = *reinterpret_cast<const bf16x8*>(Km + (16 * n + lr) * GL_QD + ks * 32 + lq * 8);
                        at[n] = __builtin_amdgcn_mfma_f32_16x16x32_bf16(a, bq, at[n], 0, 0, 0);
                    }
                }
                __syncthreads();
#pragma unroll
                for (int n = 0; n < 4; ++n)
#pragma unroll
                    for (int r = 0; r < 4; ++r) {
                        const int i = 16 * wave + 4 * lq + r, j = 16 * n + lr;
                        Att[i * GL_KT + j] = f2bf(j <= i ? at[n][r] : 0.f);
                    }
                __syncthreads();
                f32x4 o[4][2];
#pragma unroll
                for (int m = 0; m < 4; ++m)
#pragma unroll
                    for (int n = 0; n < 2; ++n) o[m][n] = (f32x4){0.f, 0.f, 0.f, 0.f};
#pragma unroll
                for (int m = 0; m < 4; ++m)
#pragma unroll
                    for (int ks = 0; ks < 2; ++ks) {
                        const bf16x8 a = *reinterpret_cast<const bf16x8*>(Att + (16 * m + lr) * GL_KT + ks * 32 + lq * 8);
#pragma unroll
                        for (int n = 0; n < 2; ++n) o[m][n] = __builtin_amdgcn_mfma_f32_16x16x32_bf16(a, vtf[ks][n], o[m][n], 0, 0, 0);
                    }
#pragma unroll
                for (int ks = 0; ks < 4; ++ks) {
                    bf16x8 sb[2];
#pragma unroll
                    for (int n = 0; n < 2; ++n) {
#pragma unroll
                        for (int r = 0; r < 4; ++r) {
                            sb[n][r] = (short)f2bf(S[2 * ks][n][r]);
                            sb[n][4 + r] = (short)f2bf(S[2 * ks + 1][n][r]);
                        }
                    }
#pragma unroll
                    for (int m = 0; m < 4; ++m) {
                        const bf16_t* qrow = Qd + (16 * m + lr) * GL_QD + ks * 32 + 4 * lq;
                        const uint2 lo = *reinterpret_cast<const uint2*>(qrow);
                        const uint2 hi = *reinterpret_cast<const uint2*>(qrow + 16);
                        union { uint4 u; bf16x8 v; } cv;
                        cv.u = make_uint4(lo.x, lo.y, hi.x, hi.y);
#pragma unroll
                        for (int n = 0; n < 2; ++n) o[m][n] = __builtin_amdgcn_mfma_f32_16x16x32_bf16(cv.v, sb[n], o[m][n], 0, 0, 0);
                    }
                }
#pragma unroll
                for (int m = 0; m < 4; ++m)
#pragma unroll
                    for (int r = 0; r < 4; ++r) {
                        const int row = scan_row(dir, j0 + 16 * m + 4 * lq + r);
                        bf16_t* og = OG + ((size_t)dir * T + row) * DGV + head * DV + vh * 128 + 32 * wave + lr;
#pragma unroll
                        for (int n = 0; n < 2; ++n) og[16 * n] = f2bf(o[m][n][r]);
                    }
            }
#pragma unroll
            for (int m = 0; m < 8; ++m) {
                const float4 eb = *reinterpret_cast<const float4*>(EB + 16 * m + 4 * lq);
#pragma unroll
                for (int n = 0; n < 2; ++n) { S[m][n][0] *= eb.x; S[m][n][1] *= eb.y; S[m][n][2] *= eb.z; S[m][n][3] *= eb.w; }
            }
#pragma unroll
            for (int ks = 0; ks < 2; ++ks)
#pragma unroll
                for (int m = 0; m < 8; ++m) {
                    const bf16x8 a = *reinterpret_cast<const bf16x8*>(KeT + (16 * m + lr) * GL_KT + ks * 32 + lq * 8);
#pragma unroll
                    for (int n = 0; n < 2; ++n) S[m][n] = __builtin_amdgcn_mfma_f32_16x16x32_bf16(a, vtf[ks][n], S[m][n], 0, 0, 0);
                }
        }
        if (MODE == 0) {
#pragma unroll
            for (int m = 0; m < 8; ++m)
#pragma unroll
                for (int n = 0; n < 2; ++n)
#pragma unroll
                    for (int r = 0; r < 4; ++r)
                        SLOC[((size_t)(unit * 4 + wave) * 64 + (m * 2 + n) * 4 + r) * 64 + lane] = S[m][n][r];
            if (vh == 0 && half == 0) DEC[(size_t)((sc * 4 + head) * 2 + dir) * 128 + k] = expf(dsum);
        }
    }
}

constexpr int GNC = T / 64;
constexpr int GLP_LDS = (64 * 16 + 4 * 64) * 4;
__device__ __forceinline__ void phase_gla_prep(const bf16_t* PB, const float* ALPHA, const float* w_alpha, const float* b_alpha,
                                               bf16_t* QD, bf16_t* KM, bf16_t* KMT, bf16_t* VTg, float* BL, char* smem, int vb,
                                               int nb, int WV) {
    const int TIDX = ltid(WV);
    float* As = (float*)smem;
    float* Bq = As + 64 * 16;
    const int tid = TIDX, kk = tid & 63, tq = tid >> 6;
    const float qscale = 0.08838834764831845f;
    for (int unit = vb; unit < GNC * 16; unit += nb) {
        const int hf = unit & 1, dir = (unit >> 1) & 1, head = (unit >> 2) & 3, ci = unit >> 4;
        const int j0 = ci * 64, k = hf * 64 + kk;
        const size_t dhc = (size_t)(dir * GH + head) * GNC + ci;
        float wcol[RANK];
#pragma unroll
        for (int r = 0; r < RANK; ++r) wcol[r] = w_alpha[(size_t)(dir * RANK + r) * DGK + head * DK + k];
        const float bcol = b_alpha[dir * DGK + head * DK + k];
        __syncthreads();
        for (int e = tid; e < 64 * 16; e += NTHR) {
            const int tt = e >> 4, r = e & 15;
            As[e] = ALPHA[(size_t)scan_row(dir, j0 + tt) * 32 + dir * 16 + r];
        }
        __syncthreads();
        float bl[16];
        {
            float b = 0.f;
#pragma unroll
            for (int i = 0; i < 16; ++i) {
                const float* ar = As + (tq * 16 + i) * 16;
                float x = bcol;
#pragma unroll
                for (int r = 0; r < RANK; ++r) x += ar[r] * wcol[r];
                b += logsigmoid_f(x) * (1.f / 16.f);
                bl[i] = b;
            }
            Bq[tq * 64 + kk] = b;
        }
        __syncthreads();
        float off = 0.f, tot = 0.f;
#pragma unroll
        for (int q = 0; q < 4; ++q) { const float v = Bq[q * 64 + kk]; off += (q < tq) ? v : 0.f; tot += v; }
        if (tq == 0) BL[dhc * 128 + k] = tot;
        unsigned kmt[8];
#pragma unroll
        for (int i = 0; i < 16; ++i) {
            const int tt = tq * 16 + i;
            const float bb = bl[i] + off;
            const bf16_t* pr = PB + (size_t)scan_row(dir, j0 + tt) * PBW;
            const float kv = bf2f(pr[PB_K + head * DK + k]);
            const float qv = bf2f(pr[PB_Q + head * DK + k]);
            const float ee = expf(bb);
            const bf16_t kmb = f2bf(kv / ee);
            QD[(dhc * 64 + tt) * 128 + k] = f2bf(qv * ee * qscale);
            KM[(dhc * 64 + tt) * 128 + k] = kmb;
            if (i & 1) kmt[i >> 1] |= (unsigned)kmb << 16; else kmt[i >> 1] = kmb;
        }
        {
            uint4* dst = reinterpret_cast<uint4*>(KMT + (dhc * 128 + k) * 64 + tq * 16);
            dst[0] = make_uint4(kmt[0], kmt[1], kmt[2], kmt[3]);
            dst[1] = make_uint4(kmt[4], kmt[5], kmt[6], kmt[7]);
        }
        {
            const int vv = tid & 127, th = tid >> 7;
            unsigned vt[16];
#pragma unroll
            for (int i = 0; i < 32; ++i) {
                const bf16_t val = PB[(size_t)scan_row(dir, j0 + th * 32 + i) * PBW + PB_V + head * DV + hf * 128 + vv];
                if (i & 1) vt[i >> 1] |= (unsigned)val << 16; else vt[i >> 1] = val;
            }
            uint4* dst = reinterpret_cast<uint4*>(VTg + (dhc * 256 + hf * 128 + vv) * 64 + th * 32);
#pragma unroll
            for (int q = 0; q < 4; ++q) dst[q] = make_uint4(vt[q * 4], vt[q * 4 + 1], vt[q * 4 + 2], vt[q * 4 + 3]);
        }
    }
}
constexpr int GLA2_LDS = 512 + 2 * 64 * GL_QD * 2 + 2 * 128 * GL_KT * 2;
template <int MODE>
__device__ __forceinline__ void phase_gla2(const bf16_t* QD, const bf16_t* KMg, const bf16_t* KMT, const bf16_t* VTg, const float* BL,
                                           float* SLOC, float* DEC, const float* SIN, bf16_t* OG, char* smem, int vb, int nb, int WV) {
    const int TIDX = ltid(WV);
    float* EB = (float*)smem;
    bf16_t* Qd = (bf16_t*)(smem + 512);
    bf16_t* Km = Qd + 64 * GL_QD;
    bf16_t* Att = Km;
    bf16_t* KeT = Km + 64 * GL_QD;
    bf16_t* VT = KeT + 128 * GL_KT;
    const int tid = TIDX, wave = tid >> 6, lane = tid & 63, lr = lane & 15, lq = lane >> 4;
    for (int unit = vb; unit < GNS * 16; unit += nb) {
        const int vh = unit & 1, dir = (unit >> 1) & 1, head = (unit >> 2) & 3, sc = unit >> 4;
        f32x4 S[8][2];
#pragma unroll
        for (int m = 0; m < 8; ++m)
#pragma unroll
            for (int n = 0; n < 2; ++n) {
                if (MODE == 0) S[m][n] = (f32x4){0.f, 0.f, 0.f, 0.f};
                else {
#pragma unroll
                    for (int r = 0; r < 4; ++r)
                        S[m][n][r] = SIN[((size_t)(unit * 4 + wave) * 64 + (m * 2 + n) * 4 + r) * 64 + lane];
                }
            }
        float dsum = 0.f;
        for (int ci = 0; ci < GSC / 64; ++ci) {
            const int j0 = sc * GSC + ci * 64;
            const size_t dhc = (size_t)(dir * GH + head) * GNC + sc * (GSC / 64) + ci;
            __syncthreads();
            if (tid < 128) { const float blv = BL[dhc * 128 + tid]; EB[tid] = expf(blv); dsum += blv; }
#pragma unroll
            for (int i = 0; i < 4; ++i) {
                const int e = tid + NTHR * i;
                if (MODE == 1) {
                    const int row = e >> 4, c16 = e & 15;
                    *reinterpret_cast<uint4*>(Qd + row * GL_QD + c16 * 8) = *reinterpret_cast<const uint4*>(QD + (dhc * 64 + row) * 128 + c16 * 8);
                    *reinterpret_cast<uint4*>(Km + row * GL_QD + c16 * 8) = *reinterpret_cast<const uint4*>(KMg + (dhc * 64 + row) * 128 + c16 * 8);
                }
                const int row8 = e >> 3, c8 = e & 7;
                *reinterpret_cast<uint4*>(VT + row8 * GL_KT + c8 * 8) =
                    *reinterpret_cast<const uint4*>(VTg + (dhc * 256 + vh * 128 + row8) * 64 + c8 * 8);
                const uint4 kw = *reinterpret_cast<const uint4*>(KMT + (dhc * 128 + row8) * 64 + c8 * 8);
                const float ebk = expf(BL[dhc * 128 + row8]);
                uint4 ko;
                ko.x = pack2bf(bflo(kw.x) * ebk, bfhi(kw.x) * ebk); ko.y = pack2bf(bflo(kw.y) * ebk, bfhi(kw.y) * ebk);
                ko.z = pack2bf(bflo(kw.z) * ebk, bfhi(kw.z) * ebk); ko.w = pack2bf(bflo(kw.w) * ebk, bfhi(kw.w) * ebk);
                *reinterpret_cast<uint4*>(KeT + row8 * GL_KT + c8 * 8) = ko;
            }
            __syncthreads();
            bf16x8 vtf[2][2];
#pragma unroll
            for (int ks = 0; ks < 2; ++ks)
#pragma unroll
                for (int n = 0; n < 2; ++n)
                    vtf[ks][n] = *reinterpret_cast<const bf16x8*>(VT + (32 * wave + 16 * n + lr) * GL_KT + ks * 32 + lq * 8);
            if (MODE == 1) {
                f32x4 at[4];
#pragma unroll
                for (int n = 0; n < 4; ++n) at[n] = (f32x4){0.f, 0.f, 0.f, 0.f};
#pragma unroll
                for (int ks = 0; ks < 4; ++ks) {
                    const bf16x8 a = *reinterpret_cast<const bf16x8*>(Qd + (16 * wave + lr) * GL_QD + ks * 32 + lq * 8);
#pragma unroll
                    for (int n = 0; n < 4; ++n) {
                        const bf16x8 bq = *reinterpret_cast<const bf16x8*>(Km + (16 * n + lr) * GL_QD + ks * 32 + lq * 8);
                        at[n] = __builtin_amdgcn_mfma_f32_16x16x32_bf16(a, bq, at[n], 0, 0, 0);
                    }
                }
                __syncthreads();
#pragma unroll
                for (int n = 0; n < 4; ++n)
#pragma unroll
                    for (int r = 0; r < 4; ++r) {
                        const int i = 16 * wave + 4 * lq + r, j = 16 * n + lr;
                        Att[i * GL_KT + j] = f2bf(j <= i ? at[n][r] : 0.f);
                    }
                __syncthreads();
                f32x4 o[4][2];
#pragma unroll
                for (int m = 0; m < 4; ++m)
#pragma unroll
                    for (int n = 0; n < 2; ++n) o[m][n] = (f32x4){0.f, 0.f, 0.f, 0.f};
#pragma unroll
                for (int m = 0; m < 4; ++m)
#pragma unroll
                    for (int ks = 0; ks < 2; ++ks) {
                        const bf16x8 a = *reinterpret_cast<const bf16x8*>(Att + (16 * m + lr) * GL_KT + ks * 32 + lq * 8);
#pragma unroll
                        for (int n = 0; n < 2; ++n) o[m][n] = __builtin_amdgcn_mfma_f32_16x16x32_bf16(a, vtf[ks][n], o[m][n], 0, 0, 0);
                    }
#pragma unroll
                for (int ks = 0; ks < 4; ++ks) {
                    bf16x8 sb[2];
#pragma unroll
                    for (int n = 0; n < 2; ++n) {
#pragma unroll
                        for (int r = 0; r < 4; ++r) {
                            sb[n][r] = (short)f2bf(S[2 * ks][n][r]);
                            sb[n][4 + r] = (short)f2bf(S[2 * ks + 1][n][r]);
                        }
                    }
#pragma unroll
                    for (int m = 0; m < 4; ++m) {
                        const bf16_t* qrow = Qd + (16 * m + lr) * GL_QD + ks * 32 + 4 * lq;
                        const uint2 lo = *reinterpret_cast<const uint2*>(qrow);
                        const uint2 hi = *reinterpret_cast<const uint2*>(qrow + 16);
                        union { uint4 u; bf16x8 v; } cv;
                        cv.u = make_uint4(lo.x, lo.y, hi.x, hi.y);
#pragma unroll
                        for (int n = 0; n < 2; ++n) o[m][n] = __builtin_amdgcn_mfma_f32_16x16x32_bf16(cv.v, sb[n], o[m][n], 0, 0, 0);
                    }
                }
#pragma unroll
                for (int m = 0; m < 4; ++m)
#pragma unroll
                    for (int r = 0; r < 4; ++r) {
                        const int row = scan_row(dir, j0 + 16 * m + 4 * lq + r);
                        bf16_t* og = OG + ((size_t)dir * T + row) * DGV + head * DV + vh * 128 + 32 * wave + lr;
#pragma unroll
                        for (int n = 0; n < 2; ++n) og[16 * n] = f2bf(o[m][n][r]);
                    }
            }
#pragma unroll
            for (int m = 0; m < 8; ++m) {
                const float4 eb = *reinterpret_cast<const float4*>(EB + 16 * m + 4 * lq);
#pragma unroll
                for (int n = 0; n < 2; ++n) { S[m][n][0] *= eb.x; S[m][n][1] *= eb.y; S[m][n][2] *= eb.z; S[m][n][3] *= eb.w; }
            }
#pragma unroll
            for (int ks = 0; ks < 2; ++ks)
#pragma unroll
                for (int m = 0; m < 8; ++m) {
                    const bf16x8 a = *reinterpret_cast<const bf16x8*>(KeT + (16 * m + lr) * GL_KT + ks * 32 + lq * 8);
#pragma unroll
                    for (int n = 0; n < 2; ++n) S[m][n] = __builtin_amdgcn_mfma_f32_16x16x32_bf16(a, vtf[ks][n], S[m][n], 0, 0, 0);
                }
        }
        if (MODE == 0) {
#pragma unroll
            for (int m = 0; m < 8; ++m)
#pragma unroll
                for (int n = 0; n < 2; ++n)
#pragma unroll
                    for (int r = 0; r < 4; ++r)
                        SLOC[((size_t)(unit * 4 + wave) * 64 + (m * 2 + n) * 4 + r) * 64 + lane] = S[m][n][r];
            if (vh == 0 && tid < 128) DEC[(size_t)((sc * 4 + head) * 2 + dir) * 128 + tid] = expf(dsum);
        }
    }
}
__device__ __forceinline__ void phase_gla_carry(const float* SLOC, const float* DEC, float* SIN, int vb, int nb, int WV) {
    const int TIDX = ltid(WV);
    for (int e = vb * NTHR + TIDX; e < 16 * GLA_UNIT_F; e += nb * NTHR) {
        const int combo = e / GLA_UNIT_F, within = e % GLA_UNIT_F;
        const int head = combo >> 2, dir = (combo >> 1) & 1;
        const int reg = (within >> 6) & 63, lane = within & 63;
        const int kk = 16 * (reg >> 3) + 4 * (lane >> 4) + (reg & 3);
        float s = 0.f;
        for (int s0 = 0; s0 < GNS; s0 += 11) {
            float sl[11], dc[11];
#pragma unroll
            for (int i = 0; i < 11; ++i) {
                sl[i] = SLOC[(size_t)((s0 + i) * 16 + combo) * GLA_UNIT_F + within];
                dc[i] = DEC[(size_t)(((s0 + i) * 4 + head) * 2 + dir) * 128 + kk];
            }
#pragma unroll
            for (int i = 0; i < 11; ++i) {
                SIN[(size_t)((s0 + i) * 16 + combo) * GLA_UNIT_F + within] = s;
                s = dc[i] * s + sl[i];
            }
        }
    }
}
static_assert(GNS % 11 == 0, "gla carry unroll");
__device__ __forceinline__ void phase_gla_finish(const bf16_t* PB, const bf16_t* OG, const float* gn, bf16_t* MIXb, float* MIXdev,
                                                 int vb, int nb, int WV) {
    const int TIDX = ltid(WV);
    const int wave = TIDX >> 6, lane = TIDX & 63;
    for (int u = vb * 4 + wave; u < T * GH; u += nb * 4) {
        const int row = u >> 2, head = u & 3;
        const size_t oi = (size_t)row * DGV + head * DV + lane * 4;
        const uint2 a = *reinterpret_cast<const uint2*>(OG + oi);
        const uint2 b = *reinterpret_cast<const uint2*>(OG + (size_t)T * DGV + oi);
        float o[4] = {bflo(a.x) + bflo(b.x), bfhi(a.x) + bfhi(b.x), bflo(a.y) + bflo(b.y), bfhi(a.y) + bfhi(b.y)};
        float ss = o[0] * o[0] + o[1] * o[1] + o[2] * o[2] + o[3] * o[3];
        ss = wave_sum(ss, lane);
        const float rs = rsqrtf(ss / DV + EPS);
        const uint2 gt = *reinterpret_cast<const uint2*>(PB + (size_t)row * PBW + PB_GATE + head * DV + lane * 4);
        const float gv[4] = {bflo(gt.x), bfhi(gt.x), bflo(gt.y), bfhi(gt.y)};
        float res[4];
#pragma unroll
        for (int i = 0; i < 4; ++i) res[i] = o[i] * rs * gn[lane * 4 + i] * silu_f(gv[i]);
        uint2 pk; pk.x = pack2bf(res[0], res[1]); pk.y = pack2bf(res[2], res[3]);
        *reinterpret_cast<uint2*>(MIXb + (size_t)row * D + DS5 + head * DV + lane * 4) = pk;
        if (MIXdev) {
#pragma unroll
            for (int i = 0; i < 4; ++i) MIXdev[(size_t)row * D + DS5 + head * DV + lane * 4 + i] = res[i];
        }
    }
}


constexpr int HYF_LDS = (64 * 36 + 64 * 64 + 64 * 64) * 4 + 256 * 66 * 2;
__device__ __forceinline__ void phase_hy_filter(const float* w1a, const float* b1a, const float* w2a, const float* b2a,
                                                const float* w3a, const float* fqa, const float* dca, bf16_t* FILT,
                                                bf16_t* FILTC, char* smem, int vb, int nb, int WV) {
    float* zs = (float*)smem;
    float* h1s = zs + 64 * 36;
    float* h2s = h1s + 64 * 64;
    bf16_t* outs = (bf16_t*)(h2s + 64 * 64);
    const int tid = ltid(WV);
    for (int unit = vb; unit < DEPTH * 132; unit += nb) {
        const int l = unit / 132, ti = unit % 132;
        const int isctx = ti >= 128, n = isctx ? CTX : SEQ, t0 = (isctx ? ti - 128 : ti) * 64;
        const float* w1 = w1a + (size_t)l * HYF * HYH; const float* b1 = b1a + (size_t)l * HYH;
        const float* w2 = w2a + (size_t)l * HYH * HYH; const float* b2 = b2a + (size_t)l * HYH;
        const float* w3 = w3a + (size_t)l * HYH * 1024; const float* fq = fqa + (size_t)l * 2 * HYH;
        const float* dc = dca + (size_t)l * 2 * DHY;
        __syncthreads();
        for (int e = tid; e < 64 * HYF; e += NTHR) {
            const int t = e / HYF, f = e % HYF, tg = t0 + t;
            const float tn = (float)tg / (float)(n - 1);
            const float w = 2.0f * 3.14159265358979323846f * (float)tg / (float)n;
            float val;
            if (f == 0) val = tn;
            else {
                const int b = (f - 1) % 16;
                const float band = 1e-4f + (float)b * ((15.0f - 1e-4f) / 15.0f);
                val = (f <= 16) ? cosf(band * w) : -sinf(band * w);
            }
            zs[t * 36 + f] = val;
        }
        __syncthreads();
        {
            const int m = tid & 63, tq = tid >> 6;
            float wc[HYF];
#pragma unroll
            for (int f = 0; f < HYF; ++f) wc[f] = w1[f * HYH + m];
            const float bb = b1[m], ff = fq[m];
            for (int i = 0; i < 16; ++i) {
                const int t = tq * 16 + i;
                float acc = bb;
#pragma unroll
                for (int f = 0; f < HYF; ++f) acc += zs[t * 36 + f] * wc[f];
                h1s[t * 64 + m] = sinf(ff * acc);
            }
        }
        __syncthreads();
        {
            const int m = tid & 63, tq = tid >> 6;
            float wc[HYH];
#pragma unroll
            for (int k = 0; k < HYH; ++k) wc[k] = w2[k * HYH + m];
            const float bb = b2[m], ff = fq[HYH + m];
            for (int i = 0; i < 16; ++i) {
                const int t = tq * 16 + i;
                float acc = bb;
#pragma unroll
                for (int k = 0; k < HYH; ++k) acc += h1s[t * 64 + k] * wc[k];
                h2s[t * 64 + m] = sinf(ff * acc);
            }
        }
        __syncthreads();
        const int wave = tid >> 6, lane = tid & 63, lr = lane & 15, lq = lane >> 4;
        bf16x8 bh[4][2], bl[4][2];
#pragma unroll
        for (int tt = 0; tt < 4; ++tt)
#pragma unroll
            for (int kh = 0; kh < 2; ++kh) {
                const float* hp = h2s + (tt * 16 + lr) * 64 + kh * 32 + lq * 8;
#pragma unroll
                for (int i = 0; i < 8; ++i) {
                    const float x = hp[i];
                    const bf16_t hi = f2bf(x);
                    bh[tt][kh][i] = (short)hi;
                    bl[tt][kh][i] = (short)f2bf(x - bf2f(hi));
                }
            }
        for (int jq = 0; jq < 4; ++jq) {
            for (int jt = 0; jt < 4; ++jt) {
                const int jloc = (wave * 4 + jt) * 16, j0 = jq * 256 + jloc;
                bf16x8 ah[2], al[2];
#pragma unroll
                for (int kh = 0; kh < 2; ++kh)
#pragma unroll
                    for (int i = 0; i < 8; ++i) {
                        const float x = w3[(size_t)(kh * 32 + lq * 8 + i) * 1024 + j0 + lr];
                        const bf16_t hi = f2bf(x);
                        ah[kh][i] = (short)hi;
                        al[kh][i] = (short)f2bf(x - bf2f(hi));
                    }
                float dk[4];
#pragma unroll
                for (int r = 0; r < 4; ++r) dk[r] = fabsf(dc[j0 + lq * 4 + r]);
#pragma unroll
                for (int tt = 0; tt < 4; ++tt) {
                    f32x4 acc = (f32x4){0.f, 0.f, 0.f, 0.f};
#pragma unroll
                    for (int kh = 0; kh < 2; ++kh) {
                        acc = __builtin_amdgcn_mfma_f32_16x16x32_bf16(al[kh], bh[tt][kh], acc, 0, 0, 0);
                        acc = __builtin_amdgcn_mfma_f32_16x16x32_bf16(ah[kh], bl[tt][kh], acc, 0, 0, 0);
                        acc = __builtin_amdgcn_mfma_f32_16x16x32_bf16(ah[kh], bh[tt][kh], acc, 0, 0, 0);
                    }
                    const int t = tt * 16 + lr;
                    const float tn = (float)(t0 + t) / (float)(n - 1);
#pragma unroll
                    for (int r = 0; r < 4; ++r) outs[(jloc + lq * 4 + r) * 66 + t] = f2bf(acc[r] * expf(-tn * dk[r]));
                }
            }
            __syncthreads();
            for (int e = tid; e < 256 * 64; e += NTHR) {
                const int jl = e >> 6, t = e & 63;
                const int jj = jq * 256 + jl, dirn = jj >> 9, c = jj & 511;
                const int lag = t0 + t;
                if (dirn == 1 && lag == 0) continue;
                const bf16_t v = outs[jl * 66 + t];
                if (isctx) FILTC[((size_t)l * DHY + c) * 512 + (dirn ? 256 - lag : 256 + lag)] = v;
                else FILT[((size_t)l * DHY + c) * 16384 + (dirn ? 8192 - lag : 8192 + lag)] = v;
            }
            __syncthreads();
        }
    }
}
constexpr int HYS_LDS = 64 * 72 * 2;
__device__ __forceinline__ void phase_hy_short(const bf16_t* PB, const float* cw, const float* cb, bf16_t* X0b, bf16_t* ST,
                                               char* smem, int vb, int nb, int WV) {
    const int TIDX = ltid(WV);
    bf16_t* ts = (bf16_t*)smem;
    const int tid = TIDX, ck = tid & 7, pl = tid >> 3;
    for (int unit = vb; unit < (T / 64) * 8; unit += nb) {
        const int rt = unit >> 3, cg = unit & 7, r0 = rt * 64;
        const int base = r0 < CTX ? 0 : CTX, n = r0 < CTX ? CTX : SEQ;
        const int c0 = cg * 64 + ck * 8;
        __syncthreads();
#pragma unroll
        for (int h = 0; h < 2; ++h) {
            const int pos = pl + 32 * h, row = r0 + pos, li = row - base;
            float z[3][8];
#pragma unroll
            for (int part = 0; part < 3; ++part) {
                const int cc = part * 512 + c0;
                const float4 b0 = *reinterpret_cast<const float4*>(cb + cc), b1 = *reinterpret_cast<const float4*>(cb + cc + 4);
                float acc[8] = {b0.x, b0.y, b0.z, b0.w, b1.x, b1.y, b1.z, b1.w};
#pragma unroll
                for (int j = 0; j < 3; ++j) {
                    const int sp = li + j - 1;
                    if (sp >= 0 && sp < n) {
                        const uint4 v = *reinterpret_cast<const uint4*>(PB + (size_t)(base + sp) * PBW + PB_HY + cc);
                        const float4 w0 = *reinterpret_cast<const float4*>(cw + j * 1536 + cc);
                        const float4 w1 = *reinterpret_cast<const float4*>(cw + j * 1536 + cc + 4);
                        acc[0] += w0.x * bflo(v.x); acc[1] += w0.y * bfhi(v.x); acc[2] += w0.z * bflo(v.y); acc[3] += w0.w * bfhi(v.y);
                        acc[4] += w1.x * bflo(v.z); acc[5] += w1.y * bfhi(v.z); acc[6] += w1.z * bflo(v.w); acc[7] += w1.w * bfhi(v.w);
                    }
                }
#pragma unroll
                for (int i = 0; i < 8; ++i) z[part][i] = acc[i];
            }
            uint4 o;
            o.x = pack2bf(z[0][0], z[0][1]); o.y = pack2bf(z[0][2], z[0][3]); o.z = pack2bf(z[0][4], z[0][5]); o.w = pack2bf(z[0][6], z[0][7]);
            *reinterpret_cast<uint4*>(X0b + (size_t)row * DHY + c0) = o;
#pragma unroll
            for (int i = 0; i < 8; ++i) ts[(ck * 8 + i) * 72 + pos] = f2bf(z[1][i] * z[2][i]);
        }
        __syncthreads();
        for (int e = tid; e < 64 * 8; e += NTHR) {
            const int ch = e >> 3, p8 = (e & 7) * 8;
            *reinterpret_cast<uint4*>(ST + (size_t)(cg * 64 + ch) * T + r0 + p8) = *reinterpret_cast<const uint4*>(ts + ch * 72 + p8);
        }
    }
}
struct __attribute__((packed, aligned(4))) HyTapQ { unsigned x, y; };
__device__ __forceinline__ bf16x8 hy_tap_frag(const bf16_t* p4, unsigned sh) {
    const HyTapQ q0 = *reinterpret_cast<const HyTapQ*>(p4), q1 = *reinterpret_cast<const HyTapQ*>(p4 + 4);
    const unsigned q2 = *reinterpret_cast<const unsigned*>(p4 + 8);
    union { uint4 u; bf16x8 v; } cv;
    cv.u = make_uint4(__builtin_amdgcn_alignbit(q0.y, q0.x, sh), __builtin_amdgcn_alignbit(q1.x, q0.y, sh), __builtin_amdgcn_alignbit(q1.y, q1.x, sh),
                      __builtin_amdgcn_alignbit(q2, q1.y, sh));
    return cv.v;
}
__device__ __forceinline__ unsigned rot16(unsigned v) { return __builtin_amdgcn_alignbit(v, v, 16); }
constexpr int HYC_LDS = 32768 + 16384;
__device__ __forceinline__ void phase_hy_conv(int l, const bf16_t* FILT, const bf16_t* FILTC, const bf16_t* ST, bf16_t* YT,
                                              char* smem, int vb, int nb, int WV) {
    const int TIDX = ltid(WV);
    bf16_t* fl = (bf16_t*)smem;
    bf16_t* xs = (bf16_t*)(smem + 32768);
    bf16_t* ys = fl;
    const int tid = TIDX, wave = tid >> 6, lane = tid & 63, lr = lane & 15, lq = lane >> 4;
    for (int unit = vb; unit < 2 * DHY; unit += nb) {
        const int seq = unit >> 9, c = unit & 511;
        const int n = seq ? CTX : SEQ, NB = n / 64, off = seq ? 0 : CTX;
        const bf16_t* F = seq ? FILTC + ((size_t)l * DHY + c) * 512 : FILT + ((size_t)l * DHY + c) * 16384;
        __syncthreads();
        for (int e = tid; e < 2 * n / 8; e += NTHR) {
            const uint4 v = reinterpret_cast<const uint4*>(F)[e];
            reinterpret_cast<uint4*>(fl)[2 * n / 8 - 1 - e] = make_uint4(rot16(v.w), rot16(v.z), rot16(v.y), rot16(v.x));
        }
        for (int e = tid; e < n / 8; e += NTHR)
            reinterpret_cast<uint4*>(xs)[e] = *reinterpret_cast<const uint4*>(ST + (size_t)c * T + off + e * 8);
        f32x4 acc[8];
#pragma unroll
        for (int i = 0; i < 8; ++i) acc[i] = (f32x4){0.f, 0.f, 0.f, 0.f};
        __syncthreads();
        const int rho = 3 - (lr & 3);
        const unsigned tsh = (rho & 1) * 16;
        const bf16_t* ga0 = fl + (n - 1) - 16 * wave - lr + 8 * lq - (rho & 1);
        if (!seq) {
            for (int r = 0; r < 16; ++r) {
                bf16x8 bq[9][2];
#pragma unroll
                for (int m = 0; m < 9; ++m) {
                    const int J = 16 * m + lr - r;
                    const bool valid = (J >= 0) && (J < 128);
                    const uint4* px = reinterpret_cast<const uint4*>(xs + 64 * (valid ? J : 0) + 8 * lq);
#pragma unroll
                    for (int ks = 0; ks < 2; ++ks) {
                        uint4 bv = px[4 * ks];
                        if ((m == 0 || m == 8) && !valid) bv = make_uint4(0u, 0u, 0u, 0u);
                        union { uint4 u; bf16x8 v; } cv;
                        cv.u = bv;
                        bq[m][ks] = cv.v;
                    }
                }
                const bf16_t* ga = ga0 - 64 * r - 1024 * 7;
#pragma unroll
                for (int si = 15; si >= 0; --si) {
                    const int sg = si - 8;
                    const bf16x8 a0 = hy_tap_frag(ga + 1024 * (7 - sg), tsh), a1 = hy_tap_frag(ga + 1024 * (7 - sg) + 32, tsh);
#pragma unroll
                    for (int m = 0; m < 9; ++m)
                        if (m + sg >= 0 && m + sg < 8) acc[m + sg] = __builtin_amdgcn_mfma_f32_16x16x32_bf16(a0, bq[m][0], acc[m + sg], 0, 0, 0);
#pragma unroll
                    for (int m = 0; m < 9; ++m)
                        if (m + sg >= 0 && m + sg < 8) acc[m + sg] = __builtin_amdgcn_mfma_f32_16x16x32_bf16(a1, bq[m][1], acc[m + sg], 0, 0, 0);
                }
            }
        } else {
            for (int dl = -(NB - 1); dl <= NB - 1; ++dl) {
                const int J = lr - dl;
                const bool valid = (J >= 0) && (J < NB);
                const int Jc = valid ? J : 0;
#pragma unroll
                for (int ks = 0; ks < 2; ++ks) {
                    const bf16x8 a = hy_tap_frag(ga0 - 64 * dl + 32 * ks, tsh);
                    uint4 bv = *reinterpret_cast<const uint4*>(xs + 64 * Jc + 32 * ks + 8 * lq);
                    if (!valid) bv = make_uint4(0u, 0u, 0u, 0u);
                    union { uint4 u; bf16x8 v; } cv;
                    cv.u = bv;
                    acc[0] = __builtin_amdgcn_mfma_f32_16x16x32_bf16(a, cv.v, acc[0], 0, 0, 0);
                }
            }
        }
        __syncthreads();
#pragma unroll
        for (int nt = 0; nt < 8; ++nt) {
            const int I = 16 * nt + lr;
            if (I < NB) {
                uint2 pk;
                pk.x = pack2bf(acc[nt][0], acc[nt][1]);
                pk.y = pack2bf(acc[nt][2], acc[nt][3]);
                *reinterpret_cast<uint2*>(ys + 64 * I + 16 * wave + 4 * lq) = pk;
            }
        }
        __syncthreads();
        for (int e = tid; e < n / 8; e += NTHR)
            *reinterpret_cast<uint4*>(YT + (size_t)c * T + off + e * 8) = reinterpret_cast<const uint4*>(ys)[e];
    }
}
constexpr int HYN_LDS = 2 * 64 * 72 * 2;
__device__ __forceinline__ void phase_hy_finish(const bf16_t* X0b, const bf16_t* ST, const bf16_t* YT, const float* bias,
                                                bf16_t* MIXb, float* MIXdev, char* smem, int vb, int nb, int WV) {
    const int TIDX = ltid(WV);
    bf16_t* ss = (bf16_t*)smem;
    bf16_t* yy = ss + 64 * 72;
    const int tid = TIDX;
    for (int unit = vb; unit < (T / 64) * 8; unit += nb) {
        const int rt = unit >> 3, cg = unit & 7, r0 = rt * 64;
        __syncthreads();
        for (int e = tid; e < 64 * 8; e += NTHR) {
            const int ch = e >> 3, p8 = (e & 7) * 8;
            *reinterpret_cast<uint4*>(ss + ch * 72 + p8) = *reinterpret_cast<const uint4*>(ST + (size_t)(cg * 64 + ch) * T + r0 + p8);
            *reinterpret_cast<uint4*>(yy + ch * 72 + p8) = *reinterpret_cast<const uint4*>(YT + (size_t)(cg * 64 + ch) * T + r0 + p8);
        }
        __syncthreads();
        for (int e = tid; e < 64 * 8; e += NTHR) {
            const int pos = e >> 3, ch0 = (e & 7) * 8, c0 = cg * 64 + ch0, row = r0 + pos;
            const uint4 xv = *reinterpret_cast<const uint4*>(X0b + (size_t)row * DHY + c0);
            const float4 b0 = *reinterpret_cast<const float4*>(bias + c0), b1 = *reinterpret_cast<const float4*>(bias + c0 + 4);
            const float xf[8] = {bflo(xv.x), bfhi(xv.x), bflo(xv.y), bfhi(xv.y), bflo(xv.z), bfhi(xv.z), bflo(xv.w), bfhi(xv.w)};
            const float bb[8] = {b0.x, b0.y, b0.z, b0.w, b1.x, b1.y, b1.z, b1.w};
            float o[8];
#pragma unroll
            for (int i = 0; i < 8; ++i) o[i] = xf[i] * (bf2f(yy[(ch0 + i) * 72 + pos]) + bb[i] * bf2f(ss[(ch0 + i) * 72 + pos]));
            uint4 ov;
            ov.x = pack2bf(o[0], o[1]); ov.y = pack2bf(o[2], o[3]); ov.z = pack2bf(o[4], o[5]); ov.w = pack2bf(o[6], o[7]);
            *reinterpret_cast<uint4*>(MIXb + (size_t)row * D + 1536 + c0) = ov;
        }
    }
}


struct EpiBf16 {
    bf16_t* C; int ldc;
    __device__ __forceinline__ void operator()(int m, int n, const f32x4& a) const {
#pragma unroll
        for (int r = 0; r < 4; ++r) C[(size_t)(m + r) * ldc + n] = f2bf(a[r]);
    }
};
__device__ __forceinline__ unsigned f_enc(float f) {
    const unsigned u = __float_as_uint(f);
    return (u & 0x80000000u) ? ~u : (u | 0x80000000u);
}
__device__ __forceinline__ float f_dec(unsigned e) {
    return __uint_as_float((e & 0x80000000u) ? (e & 0x7fffffffu) : ~e);
}
__device__ __forceinline__ void ins16(unsigned (&t)[16], unsigned c) {
#pragma unroll
    for (int j = 0; j < 16; ++j) { const unsigned hi = max(t[j], c); c = min(t[j], c); t[j] = hi; }
}
__device__ __forceinline__ void bitonic16_desc(unsigned (&m)[16]) {
#pragma unroll
    for (int d = 8; d > 0; d >>= 1)
#pragma unroll
        for (int i = 0; i < 16; ++i)
            if ((i & d) == 0) { const unsigned hi = max(m[i], m[i + d]), lo = min(m[i], m[i + d]); m[i] = hi; m[i + d] = lo; }
}
__device__ __forceinline__ void sort16_desc(unsigned (&m)[16]) {
#pragma unroll
    for (int k = 2; k <= 16; k <<= 1)
#pragma unroll
        for (int j = k >> 1; j > 0; j >>= 1)
#pragma unroll
            for (int i = 0; i < 16; ++i) {
                const int p = i ^ j;
                if (p > i) {
                    const bool desc = (i & k) == 0 || k == 16;
                    const unsigned hi = max(m[i], m[p]), lo = min(m[i], m[p]);
                    m[i] = desc ? hi : lo; m[p] = desc ? lo : hi;
                }
            }
}
__device__ __forceinline__ void merge16_desc(unsigned (&x)[16], const unsigned (&y)[16]) {
#pragma unroll
    for (int j = 0; j < 16; ++j) x[j] = max(x[j], y[15 - j]);
    bitonic16_desc(x);
}
constexpr int PSEL_STRIDE = 131, PSEL_LDS = 128 * PSEL_STRIDE * 4;
__device__ __forceinline__ void phase_peer_select(const bf16_t* Qb, const bf16_t* KEYSb  , int* IDX,
                                                  float* GATE, char* smem, int vb, int nb, int WV) {
    const int TIDX = ltid(WV);
    float* sc = (float*)smem;
    unsigned* LA = (unsigned*)smem;
    unsigned* M1 = (unsigned*)(smem + 8192);
    unsigned* LB = (unsigned*)(smem + 16384);
    const int tid = TIDX, wave = tid >> 6, lane = tid & 63, lr = lane & 15, lq = lane >> 4;
    for (int unit = vb; unit < (T / 64) * PH; unit += nb) {
        const int tt = unit >> 3, h = unit & 7, tok0 = tt * 64;
        __syncthreads();
#pragma unroll
        for (int s = 0; s < 2; ++s) {
            bf16x8 af[4];
#pragma unroll
            for (int ks = 0; ks < 4; ++ks)
                af[ks] = *reinterpret_cast<const bf16x8*>(Qb + (size_t)(tok0 + 16 * wave + lr) * D + h * PDQ + s * 128 + ks * 32 + lq * 8);
            const bf16_t* kb = KEYSb + (size_t)(h * 2 + s) * PKEYS * 128;
#pragma unroll
            for (int nt = 0; nt < 8; ++nt) {
                f32x4 acc = (f32x4){0.f, 0.f, 0.f, 0.f};
#pragma unroll
                for (int ks = 0; ks < 4; ++ks) {
                    const bf16x8 bq = *reinterpret_cast<const bf16x8*>(kb + (size_t)(16 * nt + lr) * 128 + ks * 32 + lq * 8);
                    acc = __builtin_amdgcn_mfma_f32_16x16x32_bf16(af[ks], bq, acc, 0, 0, 0);
                }
#pragma unroll
                for (int r = 0; r < 4; ++r) sc[((16 * wave + 4 * lq + r) * 2 + s) * PSEL_STRIDE + 16 * nt + lr] = acc[r];
            }
        }
        __syncthreads();
        unsigned t16[16];
        {
            const int list = tid & 127, half = tid >> 7;
            const float* sp = sc + list * PSEL_STRIDE + 64 * half;
#pragma unroll
            for (int g = 0; g < 4; ++g) {
                unsigned q16[16];
#pragma unroll
                for (int i = 0; i < 16; ++i) q16[i] = (f_enc(sp[16 * g + i]) & ~0x7fu) | (unsigned)(127 - (64 * half + 16 * g + i));
                sort16_desc(q16);
                if (g == 0) {
#pragma unroll
                    for (int i = 0; i < 16; ++i) t16[i] = q16[i];
                } else merge16_desc(t16, q16);
            }
            __syncthreads();
            if (half == 1) {
#pragma unroll
                for (int j = 0; j < 16; ++j) LA[list * 16 + j] = t16[j];
            }
            __syncthreads();
            if (half == 0) {
#pragma unroll
                for (int j = 0; j < 16; ++j) t16[j] = max(t16[j], LA[list * 16 + 15 - j]);
                bitonic16_desc(t16);
#pragma unroll
                for (int j = 0; j < 16; ++j) M1[list * 16 + j] = t16[j];
            }
            __syncthreads();
        }
        {
            const int tok = tid >> 2, aq = tid & 3;
            float v1[4], v2[16];
#pragma unroll
            for (int a = 0; a < 4; ++a) v1[a] = f_dec(M1[(tok * 2 + 0) * 16 + 4 * aq + a] & ~0x7fu);
#pragma unroll
            for (int b = 0; b < 16; ++b) v2[b] = f_dec(M1[(tok * 2 + 1) * 16 + b] & ~0x7fu);
            unsigned c16[16];
#pragma unroll
            for (int a = 0; a < 4; ++a) {
                unsigned r16[16];
#pragma unroll
                for (int b = 0; b < 16; ++b) r16[b] = (f_enc(v1[a] + v2[b]) & ~0xffu) | (unsigned)(255 - ((4 * aq + a) * 16 + b));
                if (a == 0) {
#pragma unroll
                    for (int b = 0; b < 16; ++b) c16[b] = r16[b];
                } else merge16_desc(c16, r16);
            }
#pragma unroll
            for (int round = 0; round < 2; ++round) {
                const int stride = 1 << round;
                const bool sender = (aq & (2 * stride - 1)) == stride;
                const bool recver = (aq & (2 * stride - 1)) == 0;
                if (sender) {
#pragma unroll
                    for (int j = 0; j < 16; ++j) LB[(tok * 4 + aq) * 16 + j] = c16[j];
                }
                __syncthreads();
                if (recver) {
#pragma unroll
                    for (int j = 0; j < 16; ++j) c16[j] = max(c16[j], LB[(tok * 4 + aq + stride) * 16 + 15 - j]);
                    bitonic16_desc(c16);
                }
                __syncthreads();
            }
            if (aq == 0) {
                float sv[16]; int ex[16];
#pragma unroll
                for (int j = 0; j < 16; ++j) {
                    const unsigned flat = 255u - (c16[j] & 0xffu);
                    sv[j] = f_dec(c16[j] & ~0xffu);
                    const unsigned k1 = M1[(tok * 2 + 0) * 16 + (flat >> 4)], k2 = M1[(tok * 2 + 1) * 16 + (flat & 15u)];
                    ex[j] = (int)((127u - (k1 & 0x7fu)) * PKEYS + (127u - (k2 & 0x7fu)));
                }
                float sum = 0.f, ev[16];
#pragma unroll
                for (int j = 0; j < 16; ++j) { ev[j] = expf(sv[j] - sv[0]); sum += ev[j]; }
                const float inv = 1.f / sum;
                int* ip = IDX + (size_t)(tok0 + tok) * 128 + h * 16;
                float* gp = GATE + (size_t)(tok0 + tok) * 128 + h * 16;
#pragma unroll
                for (int j = 0; j < 16; ++j) { ip[j] = ex[j]; gp[j] = ev[j] * inv; }
            }
        }
    }
}

#define XB_TMO      128
#define XB_XCNT(j)  (256  + 64 * (j))
#define XB_XSUB(j)  (1280 + 64 * (j))
#define XB_XGEN(j)  (2304 + 64 * (j))
#define XB_TOP      3328
#define XB_TOPGEN   3392
#define XCD_BAR_WORDS 3456
#define XB_SPIN_CAP (1u << 18)
#define LAS __attribute__((address_space(3)))

__device__ __forceinline__ unsigned xb_ld(unsigned* p)              { return __hip_atomic_load(p, __ATOMIC_RELAXED, __HIP_MEMORY_SCOPE_AGENT); }
__device__ __forceinline__ unsigned xb_add(unsigned* p, unsigned v) { return __hip_atomic_fetch_add(p, v, __ATOMIC_RELAXED, __HIP_MEMORY_SCOPE_AGENT); }
__device__ __forceinline__ unsigned xb_xcc_id() { return (unsigned)__builtin_amdgcn_s_getreg((3 << 11) | 20) & 0xFu; }
#define XB_SPIN(cond, bar) do { unsigned _sp = 0; while (cond) { __builtin_amdgcn_s_sleep(1); \
    if ((++_sp & 255u) == 0u) { if (xb_ld(&(bar)[XB_TMO])) break; if (_sp > XB_SPIN_CAP) { atomicAdd(&(bar)[XB_TMO], 1u); break; } } } } while (0)

struct XcdBarrier {
    unsigned* bar; unsigned x;
    volatile LAS unsigned* st;
};

__device__ __forceinline__ XcdBarrier xcd_barrier_post(unsigned* bar, volatile LAS unsigned* st) {
    XcdBarrier b; b.bar = bar; b.x = xb_xcc_id(); b.st = st;
    if (threadIdx.x == 0) (void)xb_add(&bar[XB_XCNT(b.x)], 1u);
    return b;
}
__device__ __forceinline__ void xcd_barrier_complete(unsigned* bar, unsigned x, unsigned& nloc, unsigned& nx) {
    const unsigned G = gridDim.x * gridDim.y * gridDim.z;
    unsigned sum, cnt, mine, sp = 0u;
    for (;;) {
        sum = 0u; cnt = 0u; mine = 0u;
#pragma unroll
        for (unsigned j = 0; j < 16; ++j) { const unsigned c = xb_ld(&bar[XB_XCNT(j)]); sum += c; cnt += (c > 0u) ? 1u : 0u; mine = (j == x) ? c : mine; }
        if (sum == G) break;
        __builtin_amdgcn_s_sleep(1);
        if ((++sp & 255u) == 0u) { if (xb_ld(&bar[XB_TMO])) break; if (sp > XB_SPIN_CAP) { atomicAdd(&bar[XB_TMO], 1u); break; } }
    }
    nloc = mine > 0u ? mine : 1u; nx = cnt > 0u ? cnt : 1u;
}

__device__ __forceinline__ void xcd_barrier(const XcdBarrier& b) {
    asm volatile("s_waitcnt vmcnt(0)" ::: "memory");
    __syncthreads();
    if (threadIdx.x == 0) {
        unsigned* bar = b.bar;
        __builtin_amdgcn_s_waitcnt(0);
        unsigned nloc = b.st[0], nx = b.st[1];
        if (nloc == 0u) { xcd_barrier_complete(bar, b.x, nloc, nx); b.st[0] = nloc; b.st[1] = nx; }
        const unsigned old = xb_add(&bar[XB_XSUB(b.x)], 1u);
        const unsigned gen = old / nloc;
        if (old + 1u == (gen + 1u) * nloc) {
            __builtin_amdgcn_fence(__ATOMIC_RELEASE, "agent");
            asm volatile("s_waitcnt vmcnt(0)" ::: "memory");
            const unsigned og = xb_add(&bar[XB_TOP], 1u);
            const unsigned tg = og / nx;
            if (og + 1u == (tg + 1u) * nx) xb_add(&bar[XB_TOPGEN], 1u);
            else XB_SPIN(xb_ld(&bar[XB_TOPGEN]) == tg, bar);
            __builtin_amdgcn_fence(__ATOMIC_ACQUIRE, "agent");
            xb_add(&bar[XB_XGEN(b.x)], 1u);
            asm volatile("s_waitcnt vmcnt(0)" ::: "memory");
        } else {
            XB_SPIN(xb_ld(&bar[XB_XGEN(b.x)]) == gen, bar);
            __builtin_amdgcn_fence(__ATOMIC_ACQUIRE, "agent");
            asm volatile("s_waitcnt vmcnt(0)" ::: "memory");
        }
    }
    __syncthreads();
}


__device__ __forceinline__ void grid_sync(const XcdBarrier& b0) {
    XcdBarrier b = b0;
    asm volatile("" : "+s"(b.bar), "+s"(b.x));
    xcd_barrier(b);
}

__device__ __forceinline__ void phase_init_h(const float* x, const float* ctx, float* H, int vb, int nb, int WV) {
    const int TIDX = ltid(WV);
    const int wave = TIDX >> 6, lane = TIDX & 63;
    float om[2][4];
#pragma unroll
    for (int b = 0; b < 2; ++b)
#pragma unroll
        for (int e = 0; e < 4; ++e) om[b][e] = 1.0f / powf(10000.0f, (float)(b * 256 + lane * 4 + e) / 512.0f);
    float pc[4][4];
    int cprev = -1;
    for (int row = vb * 4 + wave; row < T; row += nb * 4) {
        if (row < CTX) {
#pragma unroll
            for (int i = 0; i < 8; ++i) {
                const int d = i * 256 + lane * 4;
                *reinterpret_cast<float4*>(H + (size_t)row * D + d) = *reinterpret_cast<const float4*>(ctx + (size_t)row * D + d);
            }
            continue;
        }
        const int t = row - CTX, r = t / 64, c = t % 64;
        float4 v[8];
#pragma unroll
        for (int i = 0; i < 8; ++i) v[i] = *reinterpret_cast<const float4*>(x + (size_t)t * D + i * 256 + lane * 4);
        if (c != cprev) {
            cprev = c;
#pragma unroll
            for (int b = 0; b < 2; ++b)
#pragma unroll
                for (int e = 0; e < 4; ++e) {
                    const float a = (float)c * om[b][e];
                    pc[b][e] = sinf(a);
                    pc[2 + b][e] = cosf(a);
                }
        }
#pragma unroll
        for (int b = 0; b < 2; ++b) {
            float sr[4], cr[4];
#pragma unroll
            for (int e = 0; e < 4; ++e) {
                const float a = (float)r * om[b][e];
                sr[e] = sinf(a);
                cr[e] = cosf(a);
            }
            v[b].x += sr[0]; v[b].y += sr[1]; v[b].z += sr[2]; v[b].w += sr[3];
            v[2 + b].x += cr[0]; v[2 + b].y += cr[1]; v[2 + b].z += cr[2]; v[2 + b].w += cr[3];
            v[4 + b].x += pc[b][0]; v[4 + b].y += pc[b][1]; v[4 + b].z += pc[b][2]; v[4 + b].w += pc[b][3];
            v[6 + b].x += pc[2 + b][0]; v[6 + b].y += pc[2 + b][1]; v[6 + b].z += pc[2 + b][2]; v[6 + b].w += pc[2 + b][3];
        }
#pragma unroll
        for (int i = 0; i < 8; ++i) *reinterpret_cast<float4*>(H + (size_t)row * D + i * 256 + lane * 4) = v[i];
    }
}
constexpr int ADA_LDS = (2 * D + 4 * 128 * 2) * 4;
__device__ __forceinline__ void phase_ada(const float* c, const float* cctx, const float* w_ada, const float* b_ada, float* MOD,
                                          char* smem, int vb, int nb, int WV) {
    const int TIDX = ltid(WV);
    float* s0 = (float*)smem;
    float* s1 = s0 + D;
    float* red = s1 + D;
    const int tid = TIDX, wave = tid >> 6, lane = tid & 63;
    if (vb >= DEPTH * 96) return;
    __syncthreads();
    for (int i = tid; i < D; i += NTHR) { s0[i] = silu_f(c[i]); s1[i] = silu_f(cctx[i]); }
    __syncthreads();
    for (int unit = vb; unit < DEPTH * 96; unit += nb) {
        const int l = unit / 96, cb = unit % 96;
        const float* w = w_ada + ((size_t)l * D + wave * 512) * 6 * D + cb * 128 + lane * 2;
        float a0x = 0.f, a0y = 0.f, a1x = 0.f, a1y = 0.f;
        for (int i0 = 0; i0 < 512; i0 += 8) {
            float2 wv[8];
#pragma unroll
            for (int k = 0; k < 8; ++k) wv[k] = *reinterpret_cast<const float2*>(w + (size_t)(i0 + k) * 6 * D);
#pragma unroll
            for (int k = 0; k < 8; ++k) {
                const float f0 = s0[wave * 512 + i0 + k], f1 = s1[wave * 512 + i0 + k];
                a0x += f0 * wv[k].x; a0y += f0 * wv[k].y; a1x += f1 * wv[k].x; a1y += f1 * wv[k].y;
            }
        }
        __syncthreads();
        red[(wave * 128 + lane * 2 + 0) * 2 + 0] = a0x; red[(wave * 128 + lane * 2 + 1) * 2 + 0] = a0y;
        red[(wave * 128 + lane * 2 + 0) * 2 + 1] = a1x; red[(wave * 128 + lane * 2 + 1) * 2 + 1] = a1y;
        __syncthreads();
        {
            const int col = tid & 127, cls = tid >> 7;
            float s = b_ada[(size_t)l * 6 * D + cb * 128 + col];
#pragma unroll
            for (int w4 = 0; w4 < 4; ++w4) s += red[(w4 * 128 + col) * 2 + cls];
            MOD[((size_t)l * 2 + cls) * 6 * D + cb * 128 + col] = s;
        }
    }
}
__device__ __forceinline__ void phase_final(const float* H, const float* g, float* out, int vb, int nb, int WV) {
    const int TIDX = ltid(WV);
    const int wave = TIDX >> 6, lane = TIDX & 63;
    for (int t = vb * 4 + wave; t < SEQ; t += nb * 4) {
        const float* h = H + (size_t)(CTX + t) * D;
        float4 v[8];
        float ss = 0.f;
#pragma unroll
        for (int i = 0; i < 8; ++i) {
            v[i] = *reinterpret_cast<const float4*>(h + i * 256 + lane * 4);
            ss += v[i].x * v[i].x + v[i].y * v[i].y + v[i].z * v[i].z + v[i].w * v[i].w;
        }
        ss = wave_sum(ss, lane);
        const float rs = rsqrtf(ss / D + EPS);
#pragma unroll
        for (int i = 0; i < 8; ++i) {
            const int d = i * 256 + lane * 4;
            const float4 gg = *reinterpret_cast<const float4*>(g + d);
            float4 o;
            o.x = v[i].x * rs * gg.x; o.y = v[i].y * rs * gg.y; o.z = v[i].z * rs * gg.z; o.w = v[i].w * rs * gg.w;
            *reinterpret_cast<float4*>(out + (size_t)t * D + d) = o;
        }
    }
}

struct Params {
    const float *x, *c, *ctx, *c_ctx, *w_ada, *b_ada, *g_norm1, *g_norm2, *w_in, *s5_a_re, *s5_a_im, *s5_log_step, *s5_b_re,
        *s5_b_im, *s5_c_re, *s5_c_im, *s5_d, *s5_w_glu, *s5_b_glu, *gla_w_alpha, *gla_b_alpha, *gla_g_norm, *hy_conv_w,
        *hy_conv_b, *hy_f_w1, *hy_f_b1, *hy_f_w2, *hy_f_b2, *hy_f_w3, *hy_f_freq, *hy_decay, *hy_bias, *w_out, *peer_w_q,
        *peer_keys, *peer_u, *peer_v, *g_final;
    float* out;
    unsigned* bar;
    float *H, *MOD, *ALPHA, *SLOC, *SIN, *DEC, *GATE;
    float2 *LAM, *BBAR, *CSt, *SE, *HIN;
    bf16_t *CMb, *BBb, *GQD, *GKM, *GKMT, *GVT;
    float* GBL;
    int* IDX;
    bf16_t *WinT, *WoutT, *WqT, *WgluT, *KEYSb, *FILT, *FILTC, *A1b, *PB, *MIXb, *OGb, *X0b, *STb, *YTb, *Qb;
    float* Zf;
    unsigned char *U8, *V8;
};
constexpr int INP = 5248;
constexpr int LDS_MAX = 76032;
static_assert(GLA2_LDS <= LDS_MAX && GLP_LDS <= LDS_MAX && GEMM_LDS <= LDS_MAX && S5_LDS <= LDS_MAX && HYF_LDS <= LDS_MAX && HYC_LDS <= LDS_MAX && PSEL_LDS <= LDS_MAX &&
              ADA_LDS <= LDS_MAX && 64 * 65 * 4 <= LDS_MAX, "LDS budget");
constexpr int MEGA_LDS = LDS_MAX + 16;
extern __shared__ __attribute__((aligned(16))) char dyn_smem[];

__device__ __forceinline__ int rotb(int vb, int k, int nb) { int v = vb + (k % nb); return v >= nb ? v - nb : v; }

typedef const __attribute__((address_space(4))) Params* KArgs;
__device__ __forceinline__ KArgs kargs() {
    KArgs r = (KArgs)__builtin_amdgcn_kernarg_segment_ptr();
    asm volatile("" : "+s"(r));
    return r;
}
#define KA (kargs())
template <int S, int SUB = 7>
__device__ __forceinline__ void run_stage(int l, char* smem, int vb, int nb, int WV) {
    const float* MODl = KA->MOD + (size_t)l * 2 * 6 * D;
    if (S == 0) {
        if (SUB == 1) phase_ada(KA->c, KA->c_ctx, KA->w_ada, KA->b_ada, KA->MOD, smem, vb, nb, WV);
        if (SUB == 2) phase_hy_filter(KA->hy_f_w1, KA->hy_f_b1, KA->hy_f_w2, KA->hy_f_b2, KA->hy_f_w3, KA->hy_f_freq, KA->hy_decay, KA->FILT,
                        KA->FILTC, smem, vb, nb, WV);
        if (SUB == 3) phase_init_h(KA->x, KA->ctx, KA->H, vb, nb, WV);
        if (SUB == 4) phase_s5_tables(KA->s5_a_re, KA->s5_a_im, KA->s5_log_step, KA->s5_b_re, KA->s5_b_im, KA->s5_c_re, KA->s5_c_im, KA->LAM,
                        KA->BBAR, KA->CSt, KA->CMb, KA->BBb, vb, nb, WV);
        if (SUB == 5) {
            for (int q = 0; q < DEPTH; ++q) {
                phase_wt_convert<1>(KA->w_in + (size_t)q * D * INW, D, INW, KA->WinT + (size_t)q * INP * D, INP, smem, rotb(vb, 64 * q, nb), nb, WV);
                phase_wt_convert<0>(KA->w_out + (size_t)q * D * D, D, D, KA->WoutT + (size_t)q * D * D, D, smem, rotb(vb, 64 * q + 32, nb), nb, WV);
                phase_wt_convert<0>(KA->peer_w_q + (size_t)q * D * D, D, D, KA->WqT + (size_t)q * D * D, D, smem, rotb(vb, 64 * q + 16, nb), nb, WV);
                phase_wt_convert<0>(KA->s5_w_glu + (size_t)q * DS5 * DS5, DS5, DS5, KA->WgluT + (size_t)q * DS5 * DS5, DS5, smem,
                                    rotb(vb, 64 * q + 48, nb), nb, WV);
            }
        }
        if (SUB == 6) {
            phase_convert(KA->peer_keys, KA->KEYSb, (size_t)DEPTH * PH * 2 * PKEYS * 128, vb, nb, WV);
            phase_convert_fp6(KA->peer_u, KA->U8, DEPTH * PEXP, PEER_US6, vb, nb, WV);
            phase_convert_fp6(KA->peer_v, KA->V8, DEPTH * PEXP, PEER_VS6, vb, nb, WV);
        }
    } else if (S == 1) {
        phase_modulate_bf16(KA->H, KA->g_norm1 + (size_t)l * D, MODl, 0, D, KA->A1b, vb, nb, WV);
    } else if (S == 2) {
        gemm_phase_t<false, 128, 1>(KA->A1b, D, KA->WinT + (size_t)l * INP * D, D, T / GBM, INP / GBN, D, smem, vb, nb, WV,
                   EpiInProj{KA->PB, KA->ALPHA, nullptr});
    } else if (S == 3) {
        if (SUB & 1) phase_gla_prep(KA->PB, KA->ALPHA, KA->gla_w_alpha + (size_t)l * 2 * RANK * DGK, KA->gla_b_alpha + (size_t)l * 2 * DGK,
                                    KA->GQD, KA->GKM, KA->GKMT, KA->GVT, KA->GBL, smem, vb, nb, WV);
        if (SUB & 2) phase_s5_scan<0>(l, KA->PB, KA->LAM, KA->BBb, KA->CMb, KA->s5_d + (size_t)l * DS5, KA->SE, nullptr, nullptr, nullptr, smem,
                         rotb(vb, 16, nb), nb, WV);
        if (SUB & 4) phase_hy_short(KA->PB, KA->hy_conv_w + (size_t)l * 3 * 1536, KA->hy_conv_b + (size_t)l * 1536, KA->X0b, KA->STb, smem,
                       rotb(vb, 80, nb), nb, WV);
    } else if (S == 4) {
        if (SUB & 1) phase_hy_conv(l, KA->FILT, KA->FILTC, KA->STb, KA->YTb, smem, vb, nb, WV);
        if (SUB & 2) phase_gla_carry(KA->SLOC, KA->DEC, KA->SIN, rotb(vb, 0, nb), nb, WV);
        if (SUB & 4) phase_s5_carry(l, KA->LAM, KA->SE, KA->HIN, rotb(vb, nb - 16, nb), nb, WV);
    } else if (S == 5) {
        if (SUB & 1) phase_gla2<1>(KA->GQD, KA->GKM, KA->GKMT, KA->GVT, KA->GBL, nullptr, nullptr, KA->SIN, KA->OGb, smem, vb, nb, WV);
        if (SUB & 4) {
            constexpr int G2 = GNS * 16 - 512;
            if (nb == 512 && G2 > 0 && G2 < 512) { if (vb >= G2) phase_hy_finish(KA->X0b, KA->STb, KA->YTb, KA->hy_bias + (size_t)l * DHY, KA->MIXb, nullptr, smem, vb - G2, nb - G2, WV); }
            else phase_hy_finish(KA->X0b, KA->STb, KA->YTb, KA->hy_bias + (size_t)l * DHY, KA->MIXb, nullptr, smem, rotb(vb, 80, nb), nb, WV);
        }
    } else if (S == 13) {
        if (SUB & 1) phase_s5_scan<1>(l, KA->PB, KA->LAM, KA->BBb, KA->CMb, KA->s5_d + (size_t)l * DS5, nullptr, KA->HIN, nullptr, KA->Zf, smem,
                         vb, nb, WV);
        if (SUB & 2) phase_gla_finish(KA->PB, KA->OGb, KA->gla_g_norm + (size_t)l * DV, KA->MIXb, nullptr, rotb(vb, 64, nb), nb, WV);
    } else if (S == 6) {
        phase_gla_finish(KA->PB, KA->OGb, KA->gla_g_norm + (size_t)l * DV, KA->MIXb, nullptr, rotb(vb, 264, nb), nb, WV);
        gemm_phase_t<true, 64, 0>(reinterpret_cast<const bf16_t*>(KA->Zf), DS5, KA->WgluT + (size_t)l * DS5 * DS5, DS5, T / 64, DS5 / GBN,
                           DS5, smem, vb, nb, WV, EpiGLU{KA->Zf, KA->s5_b_glu + (size_t)l * DS5, KA->MIXb, nullptr});
    } else if (S == 7) {
        gemm_phase_t<false, 96, 2>(KA->MIXb, D, KA->WoutT + (size_t)l * D * D, D, T / 96, D / GBN, D, smem, vb, nb, WV, EpiResid{KA->H, MODl, 2 * D});
    } else if (S == 8) {
        phase_modulate_bf16(KA->H, KA->g_norm2 + (size_t)l * D, MODl, 3 * D, 4 * D, KA->A1b, vb, nb, WV);
    } else if (S == 9) {
        gemm_phase_t<false, 96, 2>(KA->A1b, D, KA->WqT + (size_t)l * D * D, D, T / 96, D / GBN, D, smem, vb, nb, WV, EpiBf16{KA->Qb, D});
    } else if (S == 10) {
        phase_peer_select(KA->Qb, KA->KEYSb + (size_t)l * PH * 2 * PKEYS * 128, KA->IDX, KA->GATE, smem, vb, nb, WV);
    } else if (S == 11) {
        phase_peer_gather(KA->A1b, KA->IDX, KA->GATE, KA->U8 + (size_t)l * PEXP * PROW, KA->V8 + (size_t)l * PEXP * PROW, MODl, KA->H,
                          l == DEPTH - 1, KA->g_norm1 + (size_t)(l + 1 < DEPTH ? l + 1 : 0) * D,
                          KA->MOD + (size_t)(l + 1 < DEPTH ? l + 1 : 0) * 2 * 6 * D, KA->A1b, KA->g_final, KA->out, smem, vb, nb, WV);
    } else if (S == 16) {
        phase_gla2<0>(KA->GQD, KA->GKM, KA->GKMT, KA->GVT, KA->GBL, KA->SLOC, KA->DEC, nullptr, nullptr, smem, vb, nb, WV);
        phase_hy_conv(l, KA->FILT, KA->FILTC, KA->STb, KA->YTb, smem, rotb(vb, 192, nb), nb, WV);
        phase_s5_carry(l, KA->LAM, KA->SE, KA->HIN, rotb(vb, nb - 16, nb), nb, WV);
    } else if (S == 17) {
        phase_gla_carry(KA->SLOC, KA->DEC, KA->SIN, vb, nb, WV);
        phase_s5_scan<1>(l, KA->PB, KA->LAM, KA->BBb, KA->CMb, KA->s5_d + (size_t)l * DS5, nullptr, KA->HIN, nullptr, KA->Zf, smem, rotb(vb, 64, nb), nb,
                         WV);
    } else if (S == 12) {
        phase_final(KA->H, KA->g_final, KA->out, vb, nb, WV);
    }
}
#ifndef MK_MULTI
#define MK_MULTI 0
#endif
#if MK_MULTI
template <int S, int SUB>
__global__ void __launch_bounds__(NTHR, 2) k_stage(Params p_unused, int l) {
    run_stage<S, SUB>(l, dyn_smem, blockIdx.x, gridDim.x, __builtin_amdgcn_readfirstlane((int)(threadIdx.x >> 6)));
}
#endif
#if !MK_MULTI
__global__ void __launch_bounds__(NTHR, 2) k_mega(Params p_unused) {
    char* smem = dyn_smem;
    if (threadIdx.x == 0) *reinterpret_cast<uint4*>(dyn_smem + LDS_MAX) = make_uint4(0u, 0u, 0u, 0u);
    __syncthreads();
    XcdBarrier xb = xcd_barrier_post(KA->bar, (volatile LAS unsigned*)(dyn_smem + LDS_MAX));
    const int vb = blockIdx.x, nb = gridDim.x;
    const int wv = __builtin_amdgcn_readfirstlane((int)(threadIdx.x >> 6));
    const bool stream_first = (((vb >> 8) ^ (vb >> 3)) & 1) != 0;
    if (stream_first) {
        run_stage<0, 6>(0, smem, vb, nb, wv);
        run_stage<0, 5>(0, smem, vb, nb, wv);
    }
    run_stage<0, 1>(0, smem, vb, nb, wv);
    run_stage<0, 2>(0, smem, rotb(vb, 384, nb), nb, wv);
    run_stage<0, 3>(0, smem, rotb(vb, 400, nb), nb, wv);
    run_stage<0, 4>(0, smem, rotb(vb, 448, nb), nb, wv);
    if (!stream_first) {
        run_stage<0, 5>(0, smem, vb, nb, wv);
        run_stage<0, 6>(0, smem, vb, nb, wv);
    }
    grid_sync(xb);
    run_stage<1>(0, smem, vb, nb, wv); grid_sync(xb);
    for (int l = 0; l < DEPTH; ++l) {
        run_stage<2>(l, smem, vb, nb, wv); grid_sync(xb);
        run_stage<3, 7>(l, smem, vb, nb, wv); grid_sync(xb);
        run_stage<16>(l, smem, vb, nb, wv); grid_sync(xb);
        run_stage<17>(l, smem, vb, nb, wv); grid_sync(xb);
        run_stage<5, 5>(l, smem, vb, nb, wv); grid_sync(xb);
        run_stage<6>(l, smem, vb, nb, wv); grid_sync(xb);
        run_stage<7>(l, smem, vb, nb, wv); grid_sync(xb);
        run_stage<8>(l, smem, vb, nb, wv); grid_sync(xb);
        run_stage<9>(l, smem, vb, nb, wv); grid_sync(xb);
        run_stage<10>(l, smem, vb, nb, wv); grid_sync(xb);
        run_stage<11>(l, smem, vb, nb, wv);
        if (l + 1 < DEPTH) grid_sync(xb);
    }
}
#endif

extern "C" void kernel_launch(void* const* d_in, const int* in_sizes, int n_in, void* d_out, int out_size, void* d_ws,
                              size_t ws_size, hipStream_t stream) {
    Params p{};
    const float** inp = reinterpret_cast<const float**>(&p);
    for (int i = 0; i < 38; ++i) inp[i] = (const float*)d_in[i];
    p.out = (float*)d_out;

    char* wp = (char*)d_ws;
    auto alloc = [&](size_t bytes) { char* r = wp; wp += (bytes + 255) & ~(size_t)255; return r; };
    p.bar = (unsigned*)alloc((size_t)XCD_BAR_WORDS * 4);
    p.H = (float*)alloc((size_t)T * D * 4);
    p.MOD = (float*)alloc((size_t)DEPTH * 2 * 6 * D * 4);
    p.ALPHA = (float*)alloc((size_t)T * 32 * 4);
    p.SLOC = (float*)alloc((size_t)GNS * 16 * GLA_UNIT_F * 4);
    p.SIN = (float*)alloc((size_t)GNS * 16 * GLA_UNIT_F * 4);
    p.DEC = (float*)alloc((size_t)GNS * 8 * 128 * 4);
    p.GATE = (float*)alloc((size_t)T * 128 * 4);
    p.LAM = (float2*)alloc((size_t)DEPTH * 2 * G5 * PS * 8);
    p.BBAR = (float2*)alloc((size_t)DEPTH * 2 * G5 * PS * CG * 8);
    p.CSt = (float2*)alloc((size_t)DEPTH * 2 * G5 * PS * CG * 8);
    p.CMb = (bf16_t*)alloc((size_t)DEPTH * 2 * G5 * CG * 128 * 2);
    p.BBb = (bf16_t*)alloc((size_t)DEPTH * 2 * G5 * 128 * 32 * 2);
    p.GQD = (bf16_t*)alloc((size_t)2 * GH * GNC * 64 * 128 * 2);
    p.GKM = (bf16_t*)alloc((size_t)2 * GH * GNC * 64 * 128 * 2);
    p.GKMT = (bf16_t*)alloc((size_t)2 * GH * GNC * 128 * 64 * 2);
    p.GVT = (bf16_t*)alloc((size_t)2 * GH * GNC * 256 * 64 * 2);
    p.GBL = (float*)alloc((size_t)2 * GH * GNC * 128 * 4);
    p.SE = (float2*)alloc((size_t)2 * G5 * S5NC * PS * 8);
    p.HIN = (float2*)alloc((size_t)2 * G5 * S5NC * PS * 8);
    p.IDX = (int*)alloc((size_t)T * 128 * 4);
    p.WinT = (bf16_t*)alloc((size_t)DEPTH * INP * D * 2);
    p.WoutT = (bf16_t*)alloc((size_t)DEPTH * D * D * 2);
    p.WqT = (bf16_t*)alloc((size_t)DEPTH * D * D * 2);
    p.WgluT = (bf16_t*)alloc((size_t)DEPTH * DS5 * DS5 * 2);
    p.KEYSb = (bf16_t*)alloc((size_t)DEPTH * PH * 2 * PKEYS * 128 * 2);
    p.U8 = (unsigned char*)alloc((size_t)DEPTH * PEXP * D);
    p.V8 = (unsigned char*)alloc((size_t)DEPTH * PEXP * D);
    p.FILT = (bf16_t*)alloc((size_t)DEPTH * DHY * 16384 * 2);
    p.FILTC = (bf16_t*)alloc((size_t)DEPTH * DHY * 512 * 2);
    p.A1b = (bf16_t*)alloc((size_t)T * D * 2);
    p.PB = (bf16_t*)alloc((size_t)T * PBW * 2);
    p.Zf = (float*)alloc((size_t)T * DS5 * 4);
    p.MIXb = (bf16_t*)alloc((size_t)T * D * 2);
    p.OGb = (bf16_t*)alloc((size_t)2 * T * DGV * 2);
    p.X0b = (bf16_t*)alloc((size_t)T * DHY * 2);
    p.STb = (bf16_t*)alloc((size_t)DHY * T * 2);
    p.YTb = (bf16_t*)alloc((size_t)DHY * T * 2);
    p.Qb = (bf16_t*)alloc((size_t)T * D * 2);
    if ((size_t)(wp - (char*)d_ws) > ws_size) fprintf(stderr, "WS OVERFLOW %zu > %zu\n", (size_t)(wp - (char*)d_ws), ws_size);

    static int grid = 0;
    if (!grid) {
        int dev = 0, cus = 0, per_cu = 0;
        (void)hipGetDevice(&dev);
        (void)hipDeviceGetAttribute(&cus, hipDeviceAttributeMultiprocessorCount, dev);
#if MK_MULTI
        per_cu = 2;
#else
        (void)hipFuncSetAttribute((const void*)k_mega, hipFuncAttributeMaxDynamicSharedMemorySize, MEGA_LDS);
        (void)hipOccupancyMaxActiveBlocksPerMultiprocessor(&per_cu, (const void*)k_mega, NTHR, MEGA_LDS);
#endif
        if (cus <= 0) cus = 256;
        grid = cus * (per_cu < 2 ? (per_cu < 1 ? 1 : per_cu) : 2);
    }
    (void)hipMemsetAsync(p.bar, 0, (size_t)XCD_BAR_WORDS * 4, stream);
#if MK_MULTI
    {
        static bool at = false;
#define SA(S, M) (void)hipFuncSetAttribute((const void*)k_stage<S, M>, hipFuncAttributeMaxDynamicSharedMemorySize, MEGA_LDS)
        if (!at) { at = true; SA(0,7); SA(1,7); SA(2,7); SA(3,7); SA(4,7); SA(5,7); SA(13,7); SA(6,7); SA(7,7); SA(8,7); SA(9,7); SA(10,7); SA(11,7); SA(12,7); }
#undef SA
#define LS(S, M, L) k_stage<S, M><<<grid, NTHR, MEGA_LDS, stream>>>(p, L)
        LS(0, 7, 0);
        for (int l = 0; l < DEPTH; ++l) {
            LS(1, 7, l); LS(2, 7, l);
            LS(3, 7, l);
            LS(4, 7, l);
            LS(5, 7, l);
            LS(13, 7, l);
            LS(6, 7, l);
            LS(7, 7, l); LS(8, 7, l); LS(9, 7, l); LS(10, 7, l); LS(11, 7, l);
        }
        LS(12, 7, 0);
#undef LS
    }
#else
    k_mega<<<grid, NTHR, MEGA_LDS, stream>>>(p);
#endif
}
```
